# Optimizing an MI355X kernel written in HIP

```python
import math
import jax, jax.numpy as jnp
from jax import lax
import numpy as np

D_MODEL = 1024
BATCH = 4
SEQ = 8192
DEPTH = 4

CHUNK = 64
N_META = 16
Q_BLOCK = 128
HEAD_DIM = 64
DIFF_WIDTH = D_MODEL // 2
FOX_WIDTH = D_MODEL - DIFF_WIDTH
DIFF_HEADS = DIFF_WIDTH // (2 * HEAD_DIM)
FOX_HEADS = FOX_WIDTH // HEAD_DIM
ROT_DIM = HEAD_DIM // 4
ROPE_THETA = 500000.0
RMS_EPS = 1e-6
SUBLN_EPS = 1e-5
COL_SIZES = (DIFF_WIDTH, DIFF_WIDTH, DIFF_WIDTH, DIFF_WIDTH,
             FOX_WIDTH, FOX_WIDTH, FOX_WIDTH, FOX_HEADS, FOX_WIDTH)
D_IN = 4 * DIFF_WIDTH + 4 * FOX_WIDTH + FOX_HEADS

kernel_name = "hymba_diff_fox_streaming_trunk"


def rmsnorm(x, gain, eps=RMS_EPS):
    xf = x.astype(jnp.float32)
    y = xf * lax.rsqrt(jnp.mean(xf * xf, axis=-1, keepdims=True) + eps)
    return (y * gain.astype(jnp.float32)).astype(x.dtype)


def partial_rope(t, cos, sin):
    half = ROT_DIM // 2
    t1, t2, tp = t[..., :half], t[..., half:ROT_DIM], t[..., ROT_DIM:]
    cos = cos.astype(t.dtype)
    sin = sin.astype(t.dtype)
    return jnp.concatenate([t1 * cos - t2 * sin, t2 * cos + t1 * sin, tp], axis=-1)


def to_blocks(t, axis):
    shp = t.shape
    nb = shp[axis] // Q_BLOCK
    t = t.reshape(shp[:axis] + (nb, Q_BLOCK) + shp[axis + 1:])
    return jnp.moveaxis(t, axis, 0)


def from_blocks(o):
    o = jnp.moveaxis(o, 0, 2)
    b, h, nb, qb, d = o.shape
    return o.reshape(b, h, nb * qb, d)


def diff_attention(q, k, v, lam, chunk_ids):
    scale = HEAD_DIM ** -0.5
    q_blocks = to_blocks(q, 3)
    cq_blocks = chunk_ids.reshape(-1, Q_BLOCK)

    def step(blk):
        qb, cq = blk
        s = jnp.einsum('bhmqd,bhmkd->bhmqk', qb, k).astype(jnp.float32) * scale
        visible = chunk_ids[None, :] <= cq[:, None]
        s = jnp.where(visible, s, -jnp.inf)
        p = jax.nn.softmax(s, axis=-1)
        a = p[:, :, 0] - lam * p[:, :, 1]
        return jnp.einsum('bhqk,bhkd->bhqd', a.astype(v.dtype), v)

    return from_blocks(lax.map(step, (q_blocks, cq_blocks)))


def forgetting_attention(q, k, v, cum_logf, positions):
    scale = HEAD_DIM ** -0.5
    q_blocks = to_blocks(q, 2)
    c_blocks = jnp.moveaxis(cum_logf.reshape(cum_logf.shape[:2] + (-1, Q_BLOCK)), 2, 0)
    p_blocks = positions.reshape(-1, Q_BLOCK)

    def step(blk):
        qb, cq, pq = blk
        s = jnp.einsum('bhqd,bhkd->bhqk', qb, k).astype(jnp.float32) * scale
        s = s + cq[..., None] - cum_logf[:, :, None, :]
        visible = positions[None, :] <= pq[:, None]
        s = jnp.where(visible, s, -jnp.inf)
        p = jax.nn.softmax(s, axis=-1)
        return jnp.einsum('bhqk,bhkd->bhqd', p.astype(v.dtype), v)

    return from_blocks(lax.map(step, (q_blocks, c_blocks, p_blocks)))


def setup_inputs(seed: int = 0) -> dict:
    key = jax.random.key(seed)
    ks = jax.random.split(key, 12)
    f32 = jnp.float32
    return {
        "x": jax.random.normal(ks[0], (BATCH, SEQ, D_MODEL), f32),
        "meta_tokens": jax.random.normal(ks[1], (N_META, D_MODEL), f32),
        "norm_gain": 1.0 + 0.02 * jax.random.normal(ks[2], (DEPTH, D_MODEL), f32),
        "w_in": jax.random.normal(ks[3], (DEPTH, D_MODEL, D_IN), f32) * D_MODEL ** -0.5,
        "forget_bias": 0.1 * jax.random.normal(ks[4], (DEPTH, FOX_HEADS), f32),
        "lambda_q1": 0.1 * jax.random.normal(ks[5], (DEPTH, HEAD_DIM), f32),
        "lambda_k1": 0.1 * jax.random.normal(ks[6], (DEPTH, HEAD_DIM), f32),
        "lambda_q2": 0.1 * jax.random.normal(ks[7], (DEPTH, HEAD_DIM), f32),
        "lambda_k2": 0.1 * jax.random.normal(ks[8], (DEPTH, HEAD_DIM), f32),
        "subln_gain": 1.0 + 0.02 * jax.random.normal(ks[9], (DEPTH, 2 * HEAD_DIM), f32),
        "w_out": jax.random.normal(ks[10], (DEPTH, D_MODEL, D_MODEL), f32) * D_MODEL ** -0.5,
        "final_gain": 1.0 + 0.02 * jax.random.normal(ks[11], (D_MODEL,), f32),
    }


def reference(x, meta_tokens, norm_gain, w_in, forget_bias, lambda_q1, lambda_k1,
              lambda_q2, lambda_k2, subln_gain, w_out, final_gain):
    b, seq, d = x.shape
    total = N_META + seq
    lp = ((total + Q_BLOCK - 1) // Q_BLOCK) * Q_BLOCK
    meta = jnp.broadcast_to(meta_tokens.astype(x.dtype)[None], (b, N_META, d))
    h = jnp.concatenate([meta, x], axis=1)
    h = jnp.pad(h, ((0, 0), (0, lp - total), (0, 0)))

    positions = jnp.arange(lp, dtype=jnp.int32)
    chunk_ids = jnp.where(positions < N_META, 0, (positions - N_META) // CHUNK + 1)
    inv_freq = 1.0 / (ROPE_THETA ** (jnp.arange(0, ROT_DIM, 2, dtype=jnp.float32) / ROT_DIM))
    ang = positions.astype(jnp.float32)[:, None] * inv_freq[None, :]
    cos = jnp.cos(ang)[None, :, None, None, :]
    sin = jnp.sin(ang)[None, :, None, None, :]
    split_points = [int(v) for v in np.cumsum(COL_SIZES)[:-1]]

    for l in range(DEPTH):
        hn = rmsnorm(h, norm_gain[l])
        proj = hn @ w_in[l]
        dq, dk, dv, dg, fq, fk, fv, ff, fg = jnp.split(proj, split_points, axis=-1)

        dq = partial_rope(dq.reshape(b, lp, DIFF_HEADS, 2, HEAD_DIM), cos, sin)
        dk = partial_rope(dk.reshape(b, lp, DIFF_HEADS, 2, HEAD_DIM), cos, sin)
        dq = jnp.transpose(dq, (0, 2, 3, 1, 4))
        dk = jnp.transpose(dk, (0, 2, 3, 1, 4))
        dv = jnp.transpose(dv.reshape(b, lp, DIFF_HEADS, 2 * HEAD_DIM), (0, 2, 1, 3))
        lam_init = 0.8 - 0.6 * math.exp(-0.3 * l)
        lam = (jnp.exp(jnp.sum(lambda_q1[l].astype(jnp.float32) * lambda_k1[l].astype(jnp.float32)))
               - jnp.exp(jnp.sum(lambda_q2[l].astype(jnp.float32) * lambda_k2[l].astype(jnp.float32)))
               + lam_init)
        do = diff_attention(dq, dk, dv, lam, chunk_ids)
        do = rmsnorm(do, subln_gain[l], SUBLN_EPS) * (1.0 - lam_init)
        do = jnp.transpose(do, (0, 2, 1, 3)).reshape(b, lp, DIFF_WIDTH)
        do = do * jax.nn.silu(dg)

        fq = jnp.transpose(fq.reshape(b, lp, FOX_HEADS, HEAD_DIM), (0, 2, 1, 3))
        fk = jnp.transpose(fk.reshape(b, lp, FOX_HEADS, HEAD_DIM), (0, 2, 1, 3))
        fv = jnp.transpose(fv.reshape(b, lp, FOX_HEADS, HEAD_DIM), (0, 2, 1, 3))
        log_f = jax.nn.log_sigmoid(ff.astype(jnp.float32) + forget_bias[l].astype(jnp.float32))
        cum_logf = jnp.transpose(jnp.cumsum(log_f, axis=1), (0, 2, 1))
        fo = forgetting_attention(fq, fk, fv, cum_logf, positions)
        fo = jnp.transpose(fo, (0, 2, 1, 3)).reshape(b, lp, FOX_WIDTH)
        fo = fo * jax.nn.silu(fg)

        h = h + jnp.concatenate([do, fo], axis=-1) @ w_out[l]

    out = rmsnorm(h, final_gain)
    return out[:, N_META:N_META + seq]
```

```cpp
#include <hip/hip_runtime.h>
#include <hip/hip_cooperative_groups.h>
#include <cstdio>
#include <cstdint>
#include <cmath>
namespace cg = cooperative_groups;
namespace pg8 {
#define PG8_LAS __attribute__((address_space(3)))
typedef unsigned short bf16_t;
typedef short bf16x8 __attribute__((ext_vector_type(8)));
typedef float f32x4 __attribute__((ext_vector_type(4)));
typedef unsigned u32x4 __attribute__((ext_vector_type(4)));
constexpr int BM = 256, BK = 64, HALF = 128, HTB = HALF * BK * 2  , STAGE_BYTES = 8 * HTB, NXCD = 8, WGM = 8;

__host__ __device__ __forceinline__ int lds_byte(int r, int c) { const int st = (r >> 4) * 2 + (c >> 5), rr = r & 15, cc = c & 31, ob = rr * 64 + cc * 2; return st * 1024 + (ob ^ (((ob >> 9) & 1) << 5)); }
__host__ __device__ __forceinline__ void stage_rc(int b, int& R, int& C) { const int st = b / 1024, sb = b % 1024, swz = sb ^ (((sb >> 9) & 1) << 5); R = (st >> 1) * 16 + swz / 64; C = (st & 1) * 32 + (swz % 64) / 2; }
__host__ __device__ __forceinline__ int perm32(int rho) { const int n = rho >> 4, i = rho & 15; return 8 * (i >> 2) + 4 * n + (i & 3); }

struct Unit { int pm, pn; };
struct Gemm { const bf16_t* A; const bf16_t* Bt; int M, N, K; };

struct StaticOrder {
    int nM, nN, nwg, G, c;
    __host__ __device__ void init(int M, int N, int G_, int c_) { nM = M / BM; nN = N / BM; nwg = nM * nN; G = G_; c = c_; }
    __host__ __device__ bool next(int i, Unit& u) const {
        const long L = (long)i * G + c; if (L >= nwg) return false;
        int wgid = (int)L; { const int q = nwg / NXCD, r = nwg % NXCD, xcd = wgid % NXCD, off = wgid / NXCD; wgid = (xcd < r ? xcd * (q + 1) : r * (q + 1) + (xcd - r) * q) + off; }
        const int nig = WGM * nN, gid = wgid / nig, fm = gid * WGM, gsz = (nM - fm) < WGM ? (nM - fm) : WGM;
        u.pm = fm + ((wgid % nig) % gsz); u.pn = (wgid % nig) / gsz; return true;
    }
    __device__ __forceinline__ void a_ready(const Unit&) const {}
    __device__ __forceinline__ void done(const Unit&) const {}
};

__device__ __forceinline__ unsigned cvt_pk_bf16(float lo, float hi) { unsigned r; asm volatile("v_cvt_pk_bf16_f32 %0, %1, %2" : "=v"(r) : "v"(lo), "v"(hi)); return r; }
typedef float f32x2 __attribute__((ext_vector_type(2)));
template <class Epi, class Sched, bool ALIGN_EPI = false, bool SP2 = false>
__device__ __forceinline__ void gemm_phase(PG8_LAS unsigned char* lds, const Gemm g, const Sched& S, const Epi& E) {
    int tid_ = threadIdx.x; asm volatile("" : "+v"(tid_));
    const int tid = tid_, wid = __builtin_amdgcn_readfirstlane(tid >> 6), lane = tid & 63, wr = wid >> 2, wc = wid & 3, fr = lane & 15, fq = lane >> 4;
    const int K = g.K, nt = K / BK;
    unsigned voffA[2], voffB[2];
#pragma unroll
    for (int i = 0; i < 2; ++i) { int R, C; stage_rc(tid * 16 + i * 8192, R, C); const int Rb = Epi::PERM ? ((R & ~31) + perm32(R & 31)) : R;
        voffA[i] = (unsigned)(R * K + C) * 2u; voffB[i] = (unsigned)(Rb * K + C) * 2u; }
    const size_t kstep = (size_t)(BK * 2);
    const size_t hstep = (size_t)HALF * K * 2;
    const size_t tstep = 2 * hstep;
    const unsigned ldsw = (unsigned)wid * 1024u;
    const int aoff = lds_byte(wr * 64 + fr, fq * 8), boff = lds_byte(wc * 32 + fr, fq * 8);
#define PG8_SA(b, h) (((b) * 2 + (h)) * HTB)
#define PG8_SB(b, h) ((4 + (b) * 2 + (h)) * HTB)
#define PG8_STAGE(bufoff, gbase, voff) do { _Pragma("unroll") for (int _i = 0; _i < 2; ++_i) \
        __builtin_amdgcn_global_load_lds((const unsigned*)((const char*)(gbase) + (voff)[_i]), (PG8_LAS unsigned*)(lds + (bufoff) + ldsw + _i * 8192), 16, 0, 0); } while (0)
#define PG8_LDA(dst, b, h) do { _Pragma("unroll") for (int m = 0; m < 4; ++m) _Pragma("unroll") for (int k = 0; k < 2; ++k) dst[m][k] = *(const PG8_LAS bf16x8*)(lds + PG8_SA(b, h) + aoff + m * 2048 + k * 1024); } while (0)
#define PG8_LDB(dst, b, h) do { _Pragma("unroll") for (int n = 0; n < 2; ++n) _Pragma("unroll") for (int k = 0; k < 2; ++k) dst[n][k] = *(const PG8_LAS bf16x8*)(lds + PG8_SB(b, h) + boff + n * 2048 + k * 1024); } while (0)
#define PG8_MMA(ai, bj, At, Bt) do { __builtin_amdgcn_s_setprio(1); _Pragma("unroll") for (int m = 0; m < 4; ++m) _Pragma("unroll") for (int n = 0; n < 2; ++n) _Pragma("unroll") for (int k = 0; k < 2; ++k) \
        acc[ai][bj][m][n] = __builtin_amdgcn_mfma_f32_16x16x32_bf16(Bt[n][k], At[m][k], acc[ai][bj][m][n], 0, 0, 0); __builtin_amdgcn_s_setprio(0); } while (0)
#define PG8_WAIT_V(n) asm volatile("s_waitcnt vmcnt(" #n ")" ::: "memory")
#define PG8_WAIT_L(n) asm volatile("s_waitcnt lgkmcnt(" #n ")" ::: "memory")
#define PG8_BAR __builtin_amdgcn_s_barrier()
#define PG8_SCHED __builtin_amdgcn_sched_barrier(0)
    Unit cur, nxt; int ui = 0;
    if (!S.next(0, cur)) return;
    f32x4 acc[2][2][4][2];
#pragma unroll
    for (int a = 0; a < 2; ++a)
#pragma unroll
        for (int b = 0; b < 2; ++b)
#pragma unroll
            for (int m = 0; m < 4; ++m)
#pragma unroll
                for (int n = 0; n < 2; ++n) acc[a][b][m][n] = (f32x4){0.f, 0.f, 0.f, 0.f};
    bf16x8 At[4][2], B0[2][2], B1[2][2];
    const char* cA = (const char*)g.A + (size_t)cur.pm * tstep; const char* cB = (const char*)g.Bt + (size_t)cur.pn * tstep;
    S.a_ready(cur);
    if constexpr (SP2) {
        PG8_STAGE(PG8_SB(0, 0), cB, voffB); PG8_STAGE(PG8_SB(0, 1), cB + hstep, voffB); PG8_STAGE(PG8_SA(0, 0), cA, voffA); PG8_STAGE(PG8_SA(0, 1), cA + hstep, voffA);
        if (wr == 1) PG8_BAR;
        PG8_WAIT_V(2); PG8_BAR;
        PG8_STAGE(PG8_SB(1, 0), cB + kstep, voffB); PG8_STAGE(PG8_SA(1, 0), cA + kstep, voffA); PG8_STAGE(PG8_SB(1, 1), cB + hstep + kstep, voffB);
        PG8_WAIT_V(6); PG8_BAR;
    } else {
        PG8_STAGE(PG8_SB(0, 0), cB, voffB); PG8_STAGE(PG8_SA(0, 0), cA, voffA); PG8_STAGE(PG8_SB(0, 1), cB + hstep, voffB); PG8_STAGE(PG8_SA(0, 1), cA + hstep, voffA);
        if (wr == 1) PG8_BAR;
        PG8_WAIT_V(4); PG8_BAR;
        PG8_STAGE(PG8_SB(1, 0), cB + kstep, voffB); PG8_STAGE(PG8_SA(1, 0), cA + kstep, voffA); PG8_STAGE(PG8_SB(1, 1), cB + hstep + kstep, voffB);
        PG8_WAIT_V(6); PG8_BAR;
    }
    for (;;) {
        const bool has_next = S.next(ui + 1, nxt);
        const char* nA = has_next ? (const char*)g.A + (size_t)nxt.pm * tstep : cA; const char* nB = has_next ? (const char*)g.Bt + (size_t)nxt.pn * tstep : cB;
        for (int t = 0; t < nt; t += 2) {
            const bool last = (t == nt - 2);
            const char* a1 = cA + (size_t)(t + 1) * kstep;
            const char* a2 = last ? nA : cA + (size_t)(t + 2) * kstep; const char* b2 = last ? nB : cB + (size_t)(t + 2) * kstep;
            const char* a3 = a2 + kstep; const char* b3 = b2 + kstep;
            if (last && has_next) S.a_ready(nxt);
            if constexpr (SP2) {
            PG8_LDB(B0, 0, 0); PG8_LDB(B1, 0, 1); PG8_SCHED; PG8_LDA(At, 0, 0); PG8_STAGE(PG8_SA(1, 1), a1 + hstep, voffA);
            PG8_WAIT_V(8); PG8_WAIT_L(0); PG8_BAR; PG8_MMA(0, 0, At, B0); PG8_MMA(0, 1, At, B1); PG8_BAR; PG8_SCHED;
            PG8_LDA(At, 0, 1); PG8_STAGE(PG8_SB(0, 0), b2, voffB); PG8_STAGE(PG8_SB(0, 1), b2 + hstep, voffB); PG8_STAGE(PG8_SA(0, 0), a2, voffA);
            PG8_WAIT_V(8); PG8_WAIT_L(0); PG8_BAR; PG8_MMA(1, 0, At, B0); PG8_MMA(1, 1, At, B1); PG8_BAR; PG8_SCHED;
            PG8_LDB(B0, 1, 0); PG8_LDB(B1, 1, 1); PG8_SCHED; PG8_LDA(At, 1, 0); PG8_STAGE(PG8_SA(0, 1), a2 + hstep, voffA);
            PG8_WAIT_V(8); PG8_WAIT_L(0); PG8_BAR; PG8_MMA(0, 0, At, B0); PG8_MMA(0, 1, At, B1); PG8_BAR; PG8_SCHED;
            PG8_LDA(At, 1, 1); PG8_STAGE(PG8_SB(1, 0), b3, voffB); PG8_STAGE(PG8_SB(1, 1), b3 + hstep, voffB); PG8_STAGE(PG8_SA(1, 0), a3, voffA);
            PG8_WAIT_V(8); PG8_WAIT_L(0); PG8_BAR; PG8_MMA(1, 0, At, B0); PG8_MMA(1, 1, At, B1); PG8_BAR; PG8_SCHED;
            } else {
            PG8_LDB(B0, 0, 0); PG8_SCHED; PG8_LDA(At, 0, 0); PG8_STAGE(PG8_SA(1, 1), a1 + hstep, voffA);
            PG8_WAIT_L(8); PG8_BAR; PG8_WAIT_L(0); PG8_MMA(0, 0, At, B0); PG8_BAR; PG8_SCHED;
            PG8_LDB(B1, 0, 1); PG8_STAGE(PG8_SB(0, 0), b2, voffB);
            PG8_BAR; PG8_WAIT_L(0); PG8_MMA(0, 1, At, B1); PG8_BAR;
            PG8_LDA(At, 0, 1); PG8_STAGE(PG8_SA(0, 0), a2, voffA);
            PG8_BAR; PG8_WAIT_L(0); PG8_MMA(1, 0, At, B0); PG8_BAR; PG8_SCHED;
            PG8_STAGE(PG8_SB(0, 1), b2 + hstep, voffB);
            PG8_WAIT_V(6); PG8_BAR; PG8_MMA(1, 1, At, B1); PG8_BAR;
            PG8_LDB(B0, 1, 0); PG8_SCHED; PG8_LDA(At, 1, 0); PG8_STAGE(PG8_SA(0, 1), a2 + hstep, voffA);
            PG8_WAIT_L(8); PG8_BAR; PG8_WAIT_L(0); PG8_MMA(0, 0, At, B0); PG8_BAR; PG8_SCHED;
            PG8_LDB(B1, 1, 1); PG8_STAGE(PG8_SB(1, 0), b3, voffB);
            PG8_BAR; PG8_WAIT_L(0); PG8_MMA(0, 1, At, B1); PG8_BAR;
            PG8_LDA(At, 1, 1); PG8_STAGE(PG8_SA(1, 0), a3, voffA);
            PG8_BAR; PG8_WAIT_L(0); PG8_MMA(1, 0, At, B0); PG8_BAR; PG8_SCHED;
            PG8_STAGE(PG8_SB(1, 1), b3 + hstep, voffB);
            PG8_WAIT_V(6); PG8_BAR; PG8_MMA(1, 1, At, B1); PG8_BAR;
            }
        }
        if constexpr (ALIGN_EPI) { if (wr == 0) PG8_BAR; }
        if constexpr (!Epi::AFTER_DRAIN) { E(acc, cur, wr, wc, fr, fq); S.done(cur); }
        if (!has_next) break;
#pragma unroll
        for (int a = 0; a < 2; ++a)
#pragma unroll
            for (int b = 0; b < 2; ++b)
#pragma unroll
                for (int m = 0; m < 4; ++m)
#pragma unroll
                    for (int n = 0; n < 2; ++n) acc[a][b][m][n] = (f32x4){0.f, 0.f, 0.f, 0.f};
        cur = nxt; cA = nA; cB = nB; ++ui;
        if constexpr (ALIGN_EPI) { if (wr == 1) PG8_BAR; }
    }
    PG8_WAIT_V(0);
    if constexpr (!ALIGN_EPI) { if (wr == 0) PG8_BAR; }
    PG8_BAR;
    if constexpr (Epi::AFTER_DRAIN) { E.fused(acc, cur, wr, wc, fr, fq, lds, wid, lane); S.done(cur); }
#undef PG8_SA
#undef PG8_SB
#undef PG8_STAGE
#undef PG8_LDA
#undef PG8_LDB
#undef PG8_MMA
#undef PG8_WAIT_V
#undef PG8_WAIT_L
#undef PG8_BAR
#undef PG8_SCHED
}
}

#define LAS __attribute__((address_space(3)))
typedef unsigned short bf16_t;
typedef short bf16x8 __attribute__((ext_vector_type(8)));
typedef short s16x4 __attribute__((ext_vector_type(4)));
typedef float f32x16 __attribute__((ext_vector_type(16)));
typedef float f32x4 __attribute__((ext_vector_type(4)));
typedef float f32x2v __attribute__((ext_vector_type(2)));
typedef unsigned u32x4 __attribute__((ext_vector_type(4)));
typedef unsigned u32x2 __attribute__((ext_vector_type(2)));
typedef __bf16 bf16x2_t __attribute__((ext_vector_type(2)));

constexpr int NB = 4, SEQ = 8192, NMETA = 16, DM = 1024, DEPTH = 4;
constexpr int LP = 8320, PADF = 112;
constexpr int MROWS = NB * LP;
constexpr int DIN = 4104, NPROJ = 4096, FFCOL = 3584;
constexpr int NSEG = 256, SEGROWS = 130;
constexpr float LOG2E = 1.4426950408889634f;
constexpr float QSCALE = 0.125f * LOG2E;
constexpr int NBLK = 65;
constexpr int NUNIT_HALF = 16 * NBLK;
constexpr int LDS_BYTES = 147456;

constexpr size_t WS_CTL = 0, CTL_BYTES = 32768;
constexpr int CW_KINF = 16, CW_KINFD = 48, CW_BAR = 4096;
constexpr size_t WS_ROPE = 32768;
constexpr size_t WS_CL = WS_ROPE + (size_t)2 * LP * 8 * 4;
constexpr size_t WS_CF = WS_CL + (size_t)MROWS * 8 * 4;
constexpr size_t WS_TOT = WS_CF + (size_t)MROWS * 8 * 4;
constexpr size_t WS_WIN = (size_t)4 << 20;
constexpr size_t WS_WOUT = WS_WIN + (size_t)DEPTH * NPROJ * DM * 2;
constexpr size_t WS_H = WS_WOUT + (size_t)DEPTH * DM * DM * 2;
constexpr size_t WS_HN = WS_H + (size_t)MROWS * DM * 4;
constexpr size_t WS_QALL = WS_HN + (size_t)MROWS * DM * 2;
constexpr size_t SZ512 = (size_t)MROWS * 512 * 2;
constexpr size_t WS_KD = WS_QALL + (size_t)MROWS * DM * 2;
constexpr size_t WS_VD = WS_KD + SZ512, WS_GD = WS_VD + SZ512, WS_KF = WS_GD + SZ512, WS_VF = WS_KF + SZ512, WS_GF = WS_VF + SZ512;
constexpr size_t WS_END = WS_GF + SZ512;
constexpr size_t WS_Y = WS_KD;
static_assert(WS_Y + (size_t)MROWS * DM * 4 <= WS_END, "y overlay");
constexpr size_t WS_RSTD = WS_TOT + 256 * 8 * 4;
static_assert(WS_RSTD + (size_t)MROWS * 4 <= WS_WIN, "ws map");

struct Args {
    const float* x; const float* meta; const float* norm_gain; const float* w_in; const float* forget_bias;
    const float* lq1; const float* lk1; const float* lq2; const float* lk2; const float* subln; const float* w_out; const float* final_gain;
    float* out; unsigned char* ws;
    float lam_init[4]; float inv_freq[8];
};

__device__ __forceinline__ int rfl(int v) { return __builtin_amdgcn_readfirstlane(v); }
__device__ __forceinline__ int opaque_tid() { int t = threadIdx.x; asm volatile("" : "+v"(t)); return t; }
__device__ __forceinline__ float wave_sum(float v) {
#pragma unroll
    for (int o = 1; o < 64; o <<= 1) v += __shfl_xor(v, o);
    return v;
}
__device__ __forceinline__ unsigned f2bf(float f) { unsigned u = __builtin_bit_cast(unsigned, f); return (u + 0x7fffu + ((u >> 16) & 1u)) >> 16; }
__device__ __forceinline__ unsigned pk2(float lo, float hi) { f32x2v v = {lo, hi}; bf16x2_t b = __builtin_convertvector(v, bf16x2_t); return __builtin_bit_cast(unsigned, b); }
__device__ __forceinline__ float bf2f(unsigned short u) { return __builtin_bit_cast(float, (unsigned)u << 16); }
__device__ __forceinline__ float swap_max(float m) { auto rr = __builtin_amdgcn_permlane32_swap(__float_as_uint(m), __float_as_uint(m), false, false); return fmaxf(__uint_as_float(rr[0]), __uint_as_float(rr[1])); }
__device__ __forceinline__ float swap_add(float m) { auto rr = __builtin_amdgcn_permlane32_swap(__float_as_uint(m), __float_as_uint(m), false, false); return __uint_as_float(rr[0]) + __uint_as_float(rr[1]); }

__device__ __forceinline__ float fadd_s(float a, float b) { float r; asm("v_add_f32_e32 %0, %1, %2" : "=v"(r) : "v"(a), "v"(b)); return r; }
__device__ __forceinline__ float max3f(float a, float b, float c) { float r; asm("v_max3_f32 %0, %1, %2, %3" : "=v"(r) : "v"(a), "v"(b), "v"(c)); return r; }

struct EpiInProj {
    static constexpr bool PERM = true, AFTER_DRAIN = false;
    bf16_t* qall; bf16_t* kd; bf16_t* vd; bf16_t* gd; bf16_t* kf; bf16_t* vf; bf16_t* gf; const float* ropec; const float* ropes; unsigned* kinf; unsigned* kinfd; const float* rstd;
    __device__ __forceinline__ void operator()(const pg8::f32x4 (&acc)[2][2][4][2], const pg8::Unit& u, int wr, int wc, int fr, int fq) const {
        const int type = u.pn >> 1, half = u.pn & 1;
        bf16_t* base; int ldc = 512; float sc = 1.f; bool rope = false, silu = false;
        switch (type) {
            case 0: base = qall; ldc = 1024; sc = QSCALE; rope = true; break;
            case 1: base = kd; rope = true; break;
            case 2: base = vd; break;
            case 3: base = gd; silu = true; break;
            case 4: base = qall + 512; ldc = 1024; sc = QSCALE; break;
            case 5: base = kf; break;
            case 6: base = vf; break;
            default: base = gf; silu = true; break;
        }
        base += 256 * half;
        if (type == 5 || type == 1) {
#pragma unroll
            for (int bj = 0; bj < 2; ++bj) { float mxa = 0.f;
#pragma unroll
                for (int ai = 0; ai < 2; ++ai)
#pragma unroll
                    for (int m = 0; m < 4; ++m)
#pragma unroll
                        for (int n = 0; n < 2; ++n)
#pragma unroll
                            for (int e = 0; e < 4; ++e) mxa = fmaxf(mxa, fabsf(acc[ai][bj][m][n][e]) * rstd[u.pm * 256 + wr * 64 + fr + ai * 128 + m * 16]);
#pragma unroll
                for (int o = 1; o < 64; o <<= 1) mxa = fmaxf(mxa, __shfl_xor(mxa, o));
                if (fr == 0 && fq == 0) atomicMax(type == 5 ? kinf + 4 * half + 2 * bj + (wc >> 1) : kinfd + 2 * half + bj, __float_as_uint(mxa)); }
        }
        const int row0 = u.pm * 256 + wr * 64 + fr, col0 = wc * 32 + 8 * fq;
        const bool dorope = rope && ((wc & 1) == 0);
        const float sgn = (fq == 0) ? -1.f : 1.f;
#pragma unroll
        for (int ai = 0; ai < 2; ++ai)
#pragma unroll
            for (int m = 0; m < 4; ++m) {
                const int row = row0 + ai * 128 + m * 16;
                const int tok = row & (SEQ - 1);
                bf16_t* rowp = base + (size_t)((row >> 13) * LP + PADF + NMETA + tok) * ldc + col0;
                const float scr = sc * rstd[row];
                f32x4 c0 = {1.f, 1.f, 1.f, 1.f}, c1 = c0, s0 = {0.f, 0.f, 0.f, 0.f}, s1 = s0;
                if (dorope) {
                    const int pos = NMETA + tok;
                    if (fq < 2) { c0 = *(const f32x4*)(ropec + pos * 8); c1 = *(const f32x4*)(ropec + pos * 8 + 4); s0 = *(const f32x4*)(ropes + pos * 8); s1 = *(const f32x4*)(ropes + pos * 8 + 4); }
                }
#pragma unroll
                for (int bj = 0; bj < 2; ++bj) {
                    f32x4 v0 = acc[ai][bj][m][0] * scr, v1 = acc[ai][bj][m][1] * scr;
                    if (dorope) {
                        f32x4 p0, p1;
#pragma unroll
                        for (int e = 0; e < 4; ++e) { p0[e] = __shfl_xor(v0[e], 16); p1[e] = __shfl_xor(v1[e], 16); }
                        v0 = v0 * c0 + (p0 * s0) * sgn; v1 = v1 * c1 + (p1 * s1) * sgn;
                    }
                    if (silu) {
#pragma unroll
                        for (int e = 0; e < 4; ++e) { v0[e] = v0[e] * __builtin_amdgcn_rcpf(1.f + __builtin_amdgcn_exp2f(-LOG2E * v0[e])); v1[e] = v1[e] * __builtin_amdgcn_rcpf(1.f + __builtin_amdgcn_exp2f(-LOG2E * v1[e])); }
                    }
                    u32x4 w; w.x = pk2(v0[0], v0[1]); w.y = pk2(v0[2], v0[3]); w.z = pk2(v1[0], v1[1]); w.w = pk2(v1[2], v1[3]);
                    *(u32x4*)(rowp + bj * 128) = w;
                }
            }
    }
};
struct EpiResid {
    static constexpr bool PERM = true, AFTER_DRAIN = false;
    bf16_t* y;
    __device__ __forceinline__ void operator()(const pg8::f32x4 (&acc)[2][2][4][2], const pg8::Unit& u, int wr, int wc, int fr, int fq) const {
        const int row0 = u.pm * 256 + wr * 64 + fr, col0 = u.pn * 256 + wc * 32 + 8 * fq;
#pragma unroll
        for (int ai = 0; ai < 2; ++ai)
#pragma unroll
            for (int m = 0; m < 4; ++m) {
                bf16_t* rp = y + (size_t)(row0 + ai * 128 + m * 16) * DM + col0;
#pragma unroll
                for (int bj = 0; bj < 2; ++bj) { const f32x4 v0 = acc[ai][bj][m][0], v1 = acc[ai][bj][m][1];
                    u32x4 w; w.x = pk2(v0[0], v0[1]); w.y = pk2(v0[2], v0[3]); w.z = pk2(v1[0], v1[1]); w.w = pk2(v1[2], v1[3]);
                    *(u32x4*)(rp + bj * 128) = w; }
            }
    }
};

constexpr int GTOK = NB * SEQ;
__device__ __forceinline__ int g_row(int b, int P) { return P >= PADF + NMETA ? b * SEQ + (P - PADF - NMETA) : (P >= PADF ? GTOK + b * NMETA + (P - PADF) : -1); }
__device__ __forceinline__ void meta_outproj(LAS unsigned char* lds, const bf16_t* __restrict__ AO, const bf16_t* __restrict__ Wt, bf16_t* __restrict__ Y) {
    const int tid = opaque_tid(), lane = tid & 63, wid = rfl(tid >> 6);
    typedef float f32x4m __attribute__((ext_vector_type(4)));
    LAS f32x4m* part = (LAS f32x4m*)lds;
    for (int blk = blockIdx.x; blk < 256; blk += gridDim.x) {
        const int rb = blk >> 6, cb = blk & 63;
        const bf16_t* ap = AO + (size_t)(GTOK + 16 * rb + (lane & 15)) * DM + 8 * (lane >> 4) + 128 * wid;
        const bf16_t* bp = Wt + (size_t)(16 * cb + (lane & 15)) * DM + 8 * (lane >> 4) + 128 * wid;
        f32x4m acc = {0.f, 0.f, 0.f, 0.f};
#pragma unroll
        for (int ks = 0; ks < 4; ++ks) { const bf16x8 av = *(const bf16x8*)(ap + 32 * ks), bv = *(const bf16x8*)(bp + 32 * ks); acc = __builtin_amdgcn_mfma_f32_16x16x32_bf16(av, bv, acc, 0, 0, 0); }
        part[wid * 64 + lane] = acc;
        __syncthreads();
        if (wid == 0) {
            f32x4m t = part[lane];
#pragma unroll
            for (int w = 1; w < 8; ++w) t = t + part[w * 64 + lane];
#pragma unroll
            for (int r = 0; r < 4; ++r) Y[(size_t)(GTOK + 16 * rb + 4 * (lane >> 4) + r) * DM + 16 * cb + (lane & 15)] = (bf16_t)(pk2(t[r], 0.f) & 0xffffu);
        }
        __syncthreads();
    }
}

__device__ __forceinline__ void meta_inproj(LAS unsigned char* lds, const bf16_t* __restrict__ H, const bf16_t* __restrict__ Wt, const EpiInProj& E) {
    const int tid = opaque_tid(), lane = tid & 63, wid = rfl(tid >> 6), blkl = wid >> 1, kh = wid & 1;
    typedef float f32x4m __attribute__((ext_vector_type(4)));
    LAS f32x4m* part = (LAS f32x4m*)lds;
    for (int base = blockIdx.x * 4; base < 1024; base += gridDim.x * 4) {
        const int blk = base + blkl, rb = blk >> 8, cb = blk & 255;
        const bf16_t* ap = H + (size_t)(GTOK + 16 * rb + (lane & 15)) * DM + 8 * (lane >> 4) + 512 * kh;
        const bf16_t* bp = Wt + (size_t)(16 * cb + (lane & 15)) * DM + 8 * (lane >> 4) + 512 * kh;
        f32x4m acc = {0.f, 0.f, 0.f, 0.f};
#pragma unroll 4
        for (int ks = 0; ks < 16; ++ks) { const bf16x8 av = *(const bf16x8*)(ap + 32 * ks), bv = *(const bf16x8*)(bp + 32 * ks); acc = __builtin_amdgcn_mfma_f32_16x16x32_bf16(av, bv, acc, 0, 0, 0); }
        part[wid * 64 + lane] = acc;
        __syncthreads();
        if (kh == 0) {
            const f32x4m t = part[wid * 64 + lane] + part[(wid + 1) * 64 + lane];
            const int n = 16 * cb + (lane & 15), type = n >> 9, cw = n & 511, i0 = 4 * (lane >> 4);
            const bool ropeblk = (type < 2) && ((cb & 3) == 0);
            const float sc = (type == 0 || type == 4) ? QSCALE : 1.f;
            float v[4], mxa = 0.f;
#pragma unroll
            for (int r = 0; r < 4; ++r) { const float kv = t[r] * E.rstd[GTOK + 16 * rb + i0 + r]; mxa = fmaxf(mxa, fabsf(kv)); v[r] = kv * sc; }
            if (type == 1 || type == 5) {
#pragma unroll
                for (int o = 1; o < 64; o <<= 1) mxa = fmaxf(mxa, __shfl_xor(mxa, o));
                const int cw0 = (16 * cb) & 511;
                if (lane == 0) atomicMax(type == 5 ? E.kinf + (cw0 >> 6) : E.kinfd + (cw0 >> 7), __float_as_uint(mxa));
            }
            if (ropeblk) {
                const int d = lane & 15;
#pragma unroll
                for (int r = 0; r < 4; ++r) { const float p = __shfl_xor(v[r], 8); const float c = E.ropec[(i0 + r) * 8 + (d & 7)], sn = E.ropes[(i0 + r) * 8 + (d & 7)]; v[r] = v[r] * c + (d < 8 ? -p : p) * sn; }
            }
            if (type == 3 || type == 7) {
#pragma unroll
                for (int r = 0; r < 4; ++r) v[r] = v[r] * __builtin_amdgcn_rcpf(1.f + __builtin_amdgcn_exp2f(-LOG2E * v[r]));
            }
            bf16_t* dst; int ldc = 512;
            switch (type) { case 0: dst = E.qall; ldc = 1024; break; case 1: dst = E.kd; break; case 2: dst = E.vd; break; case 3: dst = E.gd; break;
                            case 4: dst = E.qall + 512; ldc = 1024; break; case 5: dst = E.kf; break; case 6: dst = E.vf; break; default: dst = E.gf; break; }
#pragma unroll
            for (int r = 0; r < 4; ++r) dst[(size_t)(rb * LP + PADF + i0 + r) * ldc + cw] = (bf16_t)(pk2(v[r], 0.f) & 0xffffu);
        }
        __syncthreads();
    }
}

__device__ __forceinline__ void transpose_item(const float* W, int ldw, int K, bf16_t* WT, LAS float* scr, int kb, int nb, int srccol0, int lane, const float* gk) {
    const int k0 = 64 * kb, n0 = 32 * nb;
#pragma unroll 8
    for (int i = 0; i < 32; ++i) { const int kk = 2 * i + (lane >> 5); scr[kk * 33 + (lane & 31)] = W[(size_t)(k0 + kk) * ldw + srccol0 + (lane & 31)] * (gk ? gk[k0 + kk] : 1.0f); }
    asm volatile("s_waitcnt lgkmcnt(0)" ::: "memory");
    const int c = lane & 7;
#pragma unroll
    for (int j = 0; j < 4; ++j) { const int n = (lane >> 3) + 8 * j; const LAS float* s = scr + (8 * c) * 33 + n;
        u32x4 o; o.x = pk2(s[0 * 33], s[1 * 33]); o.y = pk2(s[2 * 33], s[3 * 33]); o.z = pk2(s[4 * 33], s[5 * 33]); o.w = pk2(s[6 * 33], s[7 * 33]);
        *(u32x4*)(WT + (size_t)(n0 + n) * K + k0 + 8 * c) = o; }
    asm volatile("s_waitcnt lgkmcnt(0)" ::: "memory");
}
__device__ __forceinline__ void prologue_phase(LAS unsigned char* lds, const Args& a) {
    const int tid = opaque_tid(), lane = tid & 63, wid = rfl(tid >> 6);
    LAS float* scr = (LAS float*)(lds + wid * 8448);
    const int gw = blockIdx.x * 8 + wid, NGW = gridDim.x * 8;
    constexpr int I_IN = 16 * 128, I_OUT = 16 * 32, I_L = I_IN + I_OUT;
    bf16_t* WIN = (bf16_t*)(a.ws + WS_WIN); bf16_t* WOUT = (bf16_t*)(a.ws + WS_WOUT);
    for (int it = gw; it < DEPTH * I_L; it += NGW) {
        const int l = it / I_L; int r = it % I_L;
        if (r < I_IN) { const int kb = r / 128, nb = r % 128; const int n0 = 32 * nb; const int src = n0 < FFCOL ? n0 : n0 + 8;
            transpose_item(a.w_in + (size_t)l * DM * DIN, DIN, DM, WIN + (size_t)l * NPROJ * DM, scr, kb, nb, src, lane, a.norm_gain + l * DM); }
        else { r -= I_IN; const int kb = r / 32, nb = r % 32;
            transpose_item(a.w_out + (size_t)l * DM * DM, DM, DM, WOUT + (size_t)l * DM * DM, scr, kb, nb, 32 * nb, lane, nullptr); }
    }
    float* rc = (float*)(a.ws + WS_ROPE); float* rs = rc + LP * 8;
    for (int i = blockIdx.x * 512 + tid; i < LP * 8; i += gridDim.x * 512) {
        const int pos = i >> 3, f = i & 7;
        const float ang = (float)pos * a.inv_freq[f];
        double rev = (double)ang * 0.15915494309189533577; rev -= floor(rev);
        rc[i] = __builtin_amdgcn_cosf((float)rev); rs[i] = __builtin_amdgcn_sinf((float)rev);
    }
}

__device__ __forceinline__ float dppf(float v, const int ctrl_sel) {
    const int x = __float_as_int(v); int r;
    if (ctrl_sel == 0) r = __builtin_amdgcn_update_dpp(x, x, 0xB1, 0xF, 0xF, true);
    else if (ctrl_sel == 1) r = __builtin_amdgcn_update_dpp(x, x, 0x4E, 0xF, 0xF, true);
    else if (ctrl_sel == 2) r = __builtin_amdgcn_update_dpp(x, x, 0x141, 0xF, 0xF, true);
    else r = __builtin_amdgcn_update_dpp(x, x, 0x140, 0xF, 0xF, true);
    return __int_as_float(r);
}
__device__ __forceinline__ float wsum(float v) {
    v += dppf(v, 0); v += dppf(v, 1); v += dppf(v, 2); v += dppf(v, 3);
    { auto rr = __builtin_amdgcn_permlane16_swap(__float_as_uint(v), __float_as_uint(v), false, false); v = __uint_as_float(rr[0]) + __uint_as_float(rr[1]); }
    return swap_add(v);
}
__device__ __forceinline__ void norm_phase(LAS unsigned char* lds, const Args& a, int layer) {
    const int tid = opaque_tid(), lane = tid & 63, wid = rfl(tid >> 6);
    LAS float* lf = (LAS float*)lds;
    bf16_t* H = (bf16_t*)(a.ws + WS_H); const bf16_t* Y = (const bf16_t*)(a.ws + WS_Y); float* RSTD = (float*)(a.ws + WS_RSTD); float* CL = (float*)(a.ws + WS_CL); float* TOT = (float*)(a.ws + WS_TOT);
    const float* gain = a.norm_gain + layer * DM;
    const float* wff = a.w_in + (size_t)layer * DM * DIN + FFCOL;
    LAS f32x4* wl = (LAS f32x4*)(lds + 8192);
    for (int k = tid; k < DM; k += 512) { const float gk = gain[k]; const float* p = wff + (size_t)k * DIN; const int jj = k >> 8, ln = (k & 255) >> 2, e = k & 3;
        wl[((jj * 4 + e) * 2 + 0) * 64 + ln] = *(const f32x4*)p * gk; wl[((jj * 4 + e) * 2 + 1) * 64 + ln] = *(const f32x4*)(p + 4) * gk; }
    __syncthreads();
    const float fb = a.forget_bias[layer * 8 + (lane & 7)];
    for (int seg = blockIdx.x; seg < NSEG; seg += gridDim.x) {
        const int row0 = seg * SEGROWS;
        f32x4 nh[4], ny[4];
#define NORM_LOAD(r_) do { const int row_ = row0 + (r_), b_ = row_ / LP, P_ = row_ % LP; \
            if (layer == 0) { \
                if (P_ < PADF) { _Pragma("unroll") for (int jj = 0; jj < 4; ++jj) nh[jj] = (f32x4){0.f, 0.f, 0.f, 0.f}; } \
                else { const float* src_ = (P_ < PADF + NMETA) ? a.meta + (size_t)(P_ - PADF) * DM : a.x + ((size_t)b_ * SEQ + (P_ - PADF - NMETA)) * DM; \
                    _Pragma("unroll") for (int jj = 0; jj < 4; ++jj) nh[jj] = *(const f32x4*)(src_ + 256 * jj + 4 * lane); } \
                _Pragma("unroll") for (int jj = 0; jj < 4; ++jj) ny[jj] = (f32x4){0.f, 0.f, 0.f, 0.f}; \
            } else { \
                const int gr_ = g_row(b_, P_); const size_t yr_ = (size_t)(gr_ < 0 ? 0 : gr_); \
                _Pragma("unroll") for (int jj = 0; jj < 4; ++jj) { u32x2 hb_ = *(const u32x2*)(H + yr_ * DM + 256 * jj + 4 * lane); u32x2 yb_ = *(const u32x2*)(Y + yr_ * DM + 256 * jj + 4 * lane); if (gr_ < 0) { hb_ = (u32x2){0u, 0u}; yb_ = hb_; } \
                    nh[jj] = (f32x4){__uint_as_float(hb_.x << 16), __uint_as_float(hb_.x & 0xffff0000u), __uint_as_float(hb_.y << 16), __uint_as_float(hb_.y & 0xffff0000u)}; \
                    ny[jj] = (f32x4){__uint_as_float(yb_.x << 16), __uint_as_float(yb_.x & 0xffff0000u), __uint_as_float(yb_.y << 16), __uint_as_float(yb_.y & 0xffff0000u)}; } \
            } } while (0)
        NORM_LOAD(wid);
        for (int r = wid; r < SEGROWS; r += 8) {
            const int row = row0 + r, P = row % LP, grw = g_row(row / LP, P);
            f32x4 v[4];
#pragma unroll
            for (int jj = 0; jj < 4; ++jj) v[jj] = nh[jj] + ny[jj];
            if (r + 8 < SEGROWS) NORM_LOAD(r + 8);
#pragma unroll
            for (int jj = 0; jj < 4; ++jj) { u32x2 o; o.x = pk2(v[jj].x, v[jj].y); o.y = pk2(v[jj].z, v[jj].w); if (grw >= 0) *(u32x2*)(H + (size_t)grw * DM + 256 * jj + 4 * lane) = o; }
            float ss = 0.f, acc[8];
#pragma unroll
            for (int c = 0; c < 8; ++c) acc[c] = 0.f;
#pragma unroll
            for (int jj = 0; jj < 4; ++jj) {
                ss += (v[jj].x * v[jj].x + v[jj].y * v[jj].y) + (v[jj].z * v[jj].z + v[jj].w * v[jj].w);
#pragma unroll
                for (int e = 0; e < 4; ++e) { const float xv = v[jj][e]; const f32x4 w0 = wl[((jj * 4 + e) * 2 + 0) * 64 + lane], w1 = wl[((jj * 4 + e) * 2 + 1) * 64 + lane];
#pragma unroll
                    for (int c = 0; c < 4; ++c) { acc[c] += xv * w0[c]; acc[4 + c] += xv * w1[c]; } }
            }
            ss = wsum(ss);
#pragma unroll
            for (int c = 0; c < 8; ++c) acc[c] = wsum(acc[c]);
            const float rstd = 1.0f / sqrtf(ss * (1.0f / DM) + 1e-6f);
            if (lane == 0 && grw >= 0) RSTD[grw] = rstd;
            const int lc = lane & 7;
            float z = lc == 0 ? acc[0] : lc == 1 ? acc[1] : lc == 2 ? acc[2] : lc == 3 ? acc[3] : lc == 4 ? acc[4] : lc == 5 ? acc[5] : lc == 6 ? acc[6] : acc[7];
            z = z * rstd + fb;
            float lfv = fminf(z, 0.f) - log1pf(expf(-fabsf(z)));
            if (P < PADF) lfv = 0.f;
            if (lane < 8) lf[r * 8 + lane] = lfv;
        }
#undef NORM_LOAD
        __syncthreads();
        if (wid == 0) {
            const int c = lane & 7, ch = lane >> 3;
            float vals[17], s = 0.f;
#pragma unroll
            for (int i = 0; i < 17; ++i) { const int r = ch * 17 + i; s += (r < SEGROWS) ? lf[r * 8 + c] : 0.f; vals[i] = s; }
            lf[1152 + lane] = s;
            asm volatile("s_waitcnt lgkmcnt(0)" ::: "memory");
            float off = 0.f;
#pragma unroll
            for (int k = 0; k < 7; ++k) off += (k < ch) ? lf[1152 + k * 8 + c] : 0.f;
#pragma unroll
            for (int i = 0; i < 17; ++i) { const int r = ch * 17 + i; if (r < SEGROWS) CL[(size_t)(row0 + r) * 8 + c] = vals[i] + off; }
            if (ch == 7) TOT[seg * 8 + c] = vals[16] + off;
        }
        __syncthreads();
    }
}
__device__ __forceinline__ void cumfix_phase(LAS unsigned char* lds, const Args& a) {
    const int tid = opaque_tid();
    LAS float* sc = (LAS float*)lds;
    const float* CL = (const float*)(a.ws + WS_CL); const float* TOT = (const float*)(a.ws + WS_TOT); float* CF = (float*)(a.ws + WS_CF);
    for (int seg = blockIdx.x; seg < NSEG; seg += gridDim.x) {
        const int b = seg >> 6, s = seg & 63, part = tid >> 3, c = tid & 7;
        sc[part * 8 + c] = (part < s) ? TOT[(b * 64 + part) * 8 + c] : 0.f;
        __syncthreads();
        if (tid < 8) { float t = 0.f; for (int p = 0; p < 64; ++p) t += sc[p * 8 + tid]; sc[512 + tid] = t; }
        __syncthreads();
        for (int i = tid; i < SEGROWS * 8; i += 512) CF[(size_t)seg * SEGROWS * 8 + i] = CL[(size_t)seg * SEGROWS * 8 + i] + sc[512 + (i & 7)];
        __syncthreads();
    }
}
__device__ __forceinline__ void final_phase(const Args& a) {
    const int tid = opaque_tid(), lane = tid & 63, wid = rfl(tid >> 6);
    const bf16_t* H = (const bf16_t*)(a.ws + WS_H); const bf16_t* Y = (const bf16_t*)(a.ws + WS_Y);
    f32x4 g4[4];
#pragma unroll
    for (int jj = 0; jj < 4; ++jj) g4[jj] = *(const f32x4*)(a.final_gain + 256 * jj + 4 * lane);
    for (int orow = blockIdx.x * 8 + wid; orow < NB * SEQ; orow += gridDim.x * 8) {
        const int b = orow / SEQ, s = orow % SEQ; const size_t row = (size_t)b * LP + PADF + NMETA + s;
        f32x4 v[4]; float ss = 0.f;
#pragma unroll
        for (int jj = 0; jj < 4; ++jj) { const u32x2 yb_ = *(const u32x2*)(Y + (size_t)orow * DM + 256 * jj + 4 * lane); const u32x2 hb_ = *(const u32x2*)(H + (size_t)orow * DM + 256 * jj + 4 * lane); v[jj] = (f32x4){__uint_as_float(hb_.x << 16), __uint_as_float(hb_.x & 0xffff0000u), __uint_as_float(hb_.y << 16), __uint_as_float(hb_.y & 0xffff0000u)} + (f32x4){__uint_as_float(yb_.x << 16), __uint_as_float(yb_.x & 0xffff0000u), __uint_as_float(yb_.y << 16), __uint_as_float(yb_.y & 0xffff0000u)}; ss += (v[jj].x * v[jj].x + v[jj].y * v[jj].y) + (v[jj].z * v[jj].z + v[jj].w * v[jj].w); }
        ss = wsum(ss);
        const float rstd = 1.0f / sqrtf(ss * (1.0f / DM) + 1e-6f);
#pragma unroll
        for (int jj = 0; jj < 4; ++jj) *(f32x4*)(a.out + (size_t)orow * DM + 256 * jj + 4 * lane) = v[jj] * rstd * g4[jj];
    }
}

#define XB_TMO      128
#define XB_XCNT(j)  (256  + 64 * (j))
#define XB_XSUB(j)  (1280 + 64 * (j))
#define XB_XGEN(j)  (2304 + 64 * (j))
#define XB_TOP      3328
#define XB_TOPGEN   3392
#define XCD_BAR_WORDS 3456
#define XB_SPIN_CAP (1u << 18)

__device__ __forceinline__ unsigned xb_ld(unsigned* p)              { return __hip_atomic_load(p, __ATOMIC_RELAXED, __HIP_MEMORY_SCOPE_AGENT); }
__device__ __forceinline__ unsigned xb_add(unsigned* p, unsigned v) { return __hip_atomic_fetch_add(p, v, __ATOMIC_RELAXED, __HIP_MEMORY_SCOPE_AGENT); }
__device__ __forceinline__ unsigned xb_xcc_id() { return (unsigned)__builtin_amdgcn_s_getreg((3 << 11) | 20) & 0xFu; }
#define XB_SPIN(cond, bar) do { unsigned _sp = 0; while (cond) { __builtin_amdgcn_s_sleep(1); \
    if ((++_sp & 255u) == 0u) { if (xb_ld(&(bar)[XB_TMO])) break; if (_sp > XB_SPIN_CAP) { atomicAdd(&(bar)[XB_TMO], 1u); break; } } } } while (0)

struct XcdBarrier {
    unsigned* bar; unsigned x;
    volatile LAS unsigned* st;
};

__device__ __forceinline__ XcdBarrier xcd_barrier_post(unsigned* bar, volatile LAS unsigned* st) {
    XcdBarrier b; b.bar = bar; b.x = xb_xcc_id(); b.st = st;
    if (threadIdx.x == 0) (void)xb_add(&bar[XB_XCNT(b.x)], 1u);
    return b;
}
__device__ __forceinline__ void xcd_barrier_complete(unsigned* bar, unsigned x, unsigned& nloc, unsigned& nx) {
    const unsigned G = gridDim.x * gridDim.y * gridDim.z;
    unsigned sum, cnt, mine, sp = 0u;
    for (;;) {
        sum = 0u; cnt = 0u; mine = 0u;
#pragma unroll
        for (unsigned j = 0; j < 16; ++j) { const unsigned c = xb_ld(&bar[XB_XCNT(j)]); sum += c; cnt += (c > 0u) ? 1u : 0u; mine = (j == x) ? c : mine; }
        if (sum == G) break;
        __builtin_amdgcn_s_sleep(1);
        if ((++sp & 255u) == 0u) { if (xb_ld(&bar[XB_TMO])) break; if (sp > XB_SPIN_CAP) { atomicAdd(&bar[XB_TMO], 1u); break; } }
    }
    nloc = mine > 0u ? mine : 1u; nx = cnt > 0u ? cnt : 1u;
}

__device__ __forceinline__ void xcd_barrier(const XcdBarrier& b) {
    asm volatile("s_waitcnt vmcnt(0)" ::: "memory");
    __syncthreads();
    if (threadIdx.x == 0) {
        unsigned* bar = b.bar;
        __builtin_amdgcn_s_waitcnt(0);
        unsigned nloc = b.st[0], nx = b.st[1];
        if (nloc == 0u) { xcd_barrier_complete(bar, b.x, nloc, nx); b.st[0] = nloc; b.st[1] = nx; }
        const unsigned old = xb_add(&bar[XB_XSUB(b.x)], 1u);
        const unsigned gen = old / nloc;
        if (old + 1u == (gen + 1u) * nloc) {
            __builtin_amdgcn_fence(__ATOMIC_RELEASE, "agent");
            asm volatile("s_waitcnt vmcnt(0)" ::: "memory");
            const unsigned og = xb_add(&bar[XB_TOP], 1u);
            const unsigned tg = og / nx;
            if (og + 1u == (tg + 1u) * nx) xb_add(&bar[XB_TOPGEN], 1u);
            else XB_SPIN(xb_ld(&bar[XB_TOPGEN]) == tg, bar);
            __builtin_amdgcn_fence(__ATOMIC_ACQUIRE, "agent");
            xb_add(&bar[XB_XGEN(b.x)], 1u);
            asm volatile("s_waitcnt vmcnt(0)" ::: "memory");
        } else {
            XB_SPIN(xb_ld(&bar[XB_XGEN(b.x)]) == gen, bar);
            __builtin_amdgcn_fence(__ATOMIC_ACQUIRE, "agent");
            asm volatile("s_waitcnt vmcnt(0)" ::: "memory");
        }
    }
    __syncthreads();
}

constexpr int ATT_CK = 131072, ATT_XCH = 0, ATT_UNITW = 133120;
__device__ __forceinline__ unsigned offb(unsigned row, unsigned ch) { return 256u * row + 16u * (ch ^ (((row & 3u) << 2) | ((row >> 2) & 3u))); }
__device__ __forceinline__ unsigned tr_addr(unsigned lane, unsigned cb, unsigned ks, unsigned t) {
    const unsigned h = lane >> 5, blk = (lane >> 4) & 1, q = (lane & 15) >> 2, p = lane & 3;
    return offb(16 * ks + 8 * h + 4 * t + q, 4 * cb + 2 * blk + (p >> 1)) + 8 * (p & 1);
}
__device__ __forceinline__ s16x4 vtr(LAS const unsigned char* p) { typedef short v4i16_t __attribute__((ext_vector_type(4))); return __builtin_bit_cast(s16x4, __builtin_amdgcn_ds_read_tr16_b64_v4i16((LAS v4i16_t*)p)); }
#define MFMA32(a, b, c) __builtin_amdgcn_mfma_f32_32x32x16_bf16((a), (b), (c), 0, 0, 0)

template <bool FOX>
__device__ __forceinline__ void attn_unit(LAS unsigned char* lds, int b, int g, int j, const bf16_t* __restrict__ QALL, const bf16_t* __restrict__ K, const bf16_t* __restrict__ V,
                                          const bf16_t* __restrict__ G, const float* __restrict__ CF, const float* __restrict__ subln, float lam, float oml, float kinf, bf16_t* __restrict__ AO) {
    const int tid = opaque_tid(), lane = tid & 63, wid = rfl(tid >> 6), stream = wid >> 2, wq = wid & 3, l31 = lane & 31, hi = lane >> 5;
    constexpr int NCB = FOX ? 2 : 4;
    const size_t rowb = (size_t)b * LP;
    const int q0 = j * 128, qloc128 = 32 * wq + l31, qrow = q0 + qloc128;
    const int tq = 2 * j + (wq >> 1);
    const int NT = 2 * j + 1;
    bf16x8 qf[4];
    { const bf16_t* qp = QALL + (rowb + qrow) * DM + (FOX ? 512 : 0) + 128 * g + 64 * stream + 8 * hi;
#pragma unroll
      for (int s = 0; s < 4; ++s) qf[s] = *(const bf16x8*)(qp + 16 * s); }
    float cq2 = 0.f;
    if (FOX) cq2 = CF[(rowb + qrow) * 8 + 2 * g + stream] * LOG2E;
    const int r4 = lane >> 4, c16 = lane & 15;
    const int chA = c16 ^ ((r4 << 2) | ((2 * wid) & 3)), chB = c16 ^ ((r4 << 2) | ((2 * wid + 1) & 3));
    const bf16_t* kgA = K + (rowb + 8 * wid + r4) * 512 + 128 * g + 8 * chA;
    const bf16_t* kgB = K + (rowb + 8 * wid + 4 + r4) * 512 + 128 * g + 8 * chB;
    const bf16_t* vgA = V + (rowb + 8 * wid + r4) * 512 + 128 * g + 8 * chA;
    const bf16_t* vgB = V + (rowb + 8 * wid + 4 + r4) * 512 + 128 * g + 8 * chB;
    const float* cfg = CF + (rowb + lane) * 8 + 2 * g + (wid & 1);
#define ATT_DMA(t, sb) do { const size_t ro_ = (size_t)(64 * (t)) * 512; LAS unsigned char* d_ = lds + (sb) * 32768 + wid * 2048; \
        __builtin_amdgcn_global_load_lds((const unsigned*)(kgA + ro_), (LAS unsigned*)(d_), 16, 0, 0); \
        __builtin_amdgcn_global_load_lds((const unsigned*)(kgB + ro_), (LAS unsigned*)(d_ + 1024), 16, 0, 0); \
        __builtin_amdgcn_global_load_lds((const unsigned*)(vgA + ro_), (LAS unsigned*)(d_ + 16384), 16, 0, 0); \
        __builtin_amdgcn_global_load_lds((const unsigned*)(vgB + ro_), (LAS unsigned*)(d_ + 16384 + 1024), 16, 0, 0); \
        if (FOX) __builtin_amdgcn_global_load_lds((const unsigned*)(cfg + (size_t)(64 * (t)) * 8), (LAS unsigned*)(lds + ATT_CK + (sb) * 512 + (wid & 1) * 256), 4, 0, 0); } while (0)
#define ATT_WAIT_BAR(pending) do { if (pending) { if (FOX) asm volatile("s_waitcnt vmcnt(5) lgkmcnt(0)\n\ts_barrier" ::: "memory"); else asm volatile("s_waitcnt vmcnt(4) lgkmcnt(0)\n\ts_barrier" ::: "memory"); } \
        else asm volatile("s_waitcnt vmcnt(0) lgkmcnt(0)\n\ts_barrier" ::: "memory"); } while (0)
    const unsigned krow = (l31 & ~12u) | ((l31 & 4u) << 1) | ((l31 & 8u) >> 1);
    unsigned koff[4];
#pragma unroll
    for (int s = 0; s < 4; ++s) koff[s] = offb(krow, 8 * stream + 2 * s + hi);
    unsigned voff[NCB][2];
#pragma unroll
    for (int cb = 0; cb < NCB; ++cb)
#pragma unroll
        for (int t = 0; t < 2; ++t) voff[cb][t] = 16384u + tr_addr(lane, FOX ? 2 * stream + cb : cb, 0, t);
    f32x16 o[NCB];
#pragma unroll
    for (int cb = 0; cb < NCB; ++cb)
#pragma unroll
        for (int r = 0; r < 16; ++r) o[cb][r] = 0.f;
    float lsum = 0.f;
    const int qloc64 = 32 * (wq & 1) + l31;

    constexpr float THR = 96.0f, SKIP_T = 40.0f;
    float ub = 0.f, qb;
    {
        float q1 = 0.f;
#pragma unroll
        for (int s = 0; s < 4; ++s)
#pragma unroll
            for (int e = 0; e < 8; ++e) q1 += fabsf(bf2f((unsigned short)qf[s][e]));
        q1 = swap_add(q1);
        qb = q1 * kinf * 1.01f;
        if (FOX) ub = qb + cq2 + SKIP_T;
    }
    bool needmax = true;
    volatile LAS int* flags = (volatile LAS int*)(lds + ATT_UNITW + 64);
    int t = FOX ? NT : 1;
    ATT_DMA(t, 0);
    { const int t1_ = FOX ? t - 1 : t + 1; const bool h1_ = FOX ? (t1_ >= 1) : (t1_ <= NT); if (h1_) ATT_DMA(t1_, 1); ATT_WAIT_BAR(h1_); }
    bool wmore = (tq >= 1), first = true;
    float mref = 0.f;
    f32x16 negm;
#pragma unroll
    for (int r = 0; r < 16; ++r) negm[r] = 0.f;
    bf16x8 pf[4];
#pragma unroll
    for (int s = 0; s < 4; ++s) pf[s] = (bf16x8){0, 0, 0, 0, 0, 0, 0, 0};
#define ATT_SB() __builtin_amdgcn_sched_barrier(0)
#define ATT_VRD(arr, ks) do { _Pragma("unroll") for (int cb = 0; cb < NCB; ++cb) { arr[cb][0] = vtr(vbp_ + voff[cb][0] + 4096 * (ks)); arr[cb][1] = vtr(vbp_ + voff[cb][1] + 4096 * (ks)); } } while (0)
#define ATT_MM(arr, ks) do { _Pragma("unroll") for (int cb = 0; cb < NCB; ++cb) { const bf16x8 vf = {arr[cb][0][0], arr[cb][0][1], arr[cb][0][2], arr[cb][0][3], arr[cb][1][0], arr[cb][1][1], arr[cb][1][2], arr[cb][1][3]}; o[cb] = MFMA32(vf, pf[ks], o[cb]); } } while (0)
#define ATT_EXPCH(S, B, DST) do { _Pragma("unroll") for (int r = (B); r < (B) + 8; r += 2) { S[r] = __builtin_amdgcn_exp2f(S[r]); S[r + 1] = __builtin_amdgcn_exp2f(S[r + 1]); ps2.x = fadd_s(ps2.x, S[r]); ps2.y = fadd_s(ps2.y, S[r + 1]); } \
        u32x4 w_; w_.x = pk2(S[B], S[(B) + 1]); w_.y = pk2(S[(B) + 2], S[(B) + 3]); w_.z = pk2(S[(B) + 4], S[(B) + 5]); w_.w = pk2(S[(B) + 6], S[(B) + 7]); DST = __builtin_bit_cast(bf16x8, w_); asm volatile("" : "+v"(DST), "+v"(ps2)); } while (0)
    int pbuf = 0, buf = 0;
    for (;;) {
        const int tn = FOX ? t - 1 : t + 1, tn2 = FOX ? t - 2 : t + 2;
        const bool have_next = FOX ? (tn >= 1) : (tn <= NT), have_next2 = FOX ? (tn2 >= 1) : (tn2 <= NT);
        const int nbuf = (buf + 1) & 3;
        const bool act = (t <= tq) && wmore;
        LAS const unsigned char* vbp_ = lds + pbuf * 32768;
        LAS const unsigned char* kb = lds + buf * 32768;
        s16x4 va[NCB][2];
        f32x16 s0, s1;
        float ckfirst = 0.f, alpha_o = 1.f; bool resc = false;
        if (act) {
            bf16x8 kf[8];
#pragma unroll
            for (int s = 0; s < 4; ++s) { kf[2 * s] = *(LAS const bf16x8*)(kb + koff[s]); kf[2 * s + 1] = *(LAS const bf16x8*)(kb + koff[s] + 8192); }
            if (have_next2) ATT_DMA(tn2, (buf + 2) & 3);
            if (FOX) {
                LAS const float* ck = (LAS const float*)(lds + ATT_CK + buf * 512) + 64 * stream;
                ckfirst = ck[0] * LOG2E;
                ck += 8 * hi;
                const float cqm = cq2 - mref;
#pragma unroll
                for (int rr = 0; rr < 2; ++rr) {
                    const f32x4 a0 = *(LAS const f32x4*)(ck + 16 * rr), a1 = *(LAS const f32x4*)(ck + 16 * rr + 4), b0 = *(LAS const f32x4*)(ck + 32 + 16 * rr), b1 = *(LAS const f32x4*)(ck + 32 + 16 * rr + 4);
#pragma unroll
                    for (int e = 0; e < 4; ++e) { s0[8 * rr + e] = cqm - LOG2E * a0[e]; s0[8 * rr + 4 + e] = cqm - LOG2E * a1[e]; s1[8 * rr + e] = cqm - LOG2E * b0[e]; s1[8 * rr + 4 + e] = cqm - LOG2E * b1[e]; }
                }
                ATT_SB();
                s0 = MFMA32(kf[0], qf[0], s0); s1 = MFMA32(kf[1], qf[0], s1);
            } else {
                ATT_SB();
                s0 = MFMA32(kf[0], qf[0], negm); s1 = MFMA32(kf[1], qf[0], negm);
            }
#pragma unroll
            for (int s = 1; s < 4; ++s) { s0 = MFMA32(kf[2 * s], qf[s], s0); s1 = MFMA32(kf[2 * s + 1], qf[s], s1); }
        } else {
            if (have_next2) ATT_DMA(tn2, (buf + 2) & 3);
#pragma unroll
            for (int r = 0; r < 16; ++r) { s0[r] = -INFINITY; s1[r] = -INFINITY; }
        }
        ATT_VRD(va, 0);
        ATT_SB();
        if (t == 1) {
#pragma unroll
            for (int r = 0; r < 16; ++r) s0[r] = -INFINITY;
#pragma unroll
            for (int r = 0; r < 8; ++r) s1[r] = -INFINITY;
        }
        if (FOX && t == tq) {
#pragma unroll
            for (int r = 0; r < 16; ++r) { const int kl = 16 * (r >> 3) + 8 * hi + (r & 7); if (kl > qloc64) s0[r] = -INFINITY; if (kl + 32 > qloc64) s1[r] = -INFINITY; }
        }
        float mx = 0.f; bool upd = false;
        if (needmax) {
            float mxa = max3f(s0[0], s0[1], s1[0]), mxb = max3f(s0[2], s0[3], s1[1]);
            mxa = max3f(mxa, s1[2], s1[3]);
#pragma unroll
            for (int r = 4; r < 16; r += 4) { mxa = max3f(mxa, s0[r], s0[r + 1]); mxb = max3f(mxb, s0[r + 2], s0[r + 3]); mxa = max3f(mxa, s1[r], s1[r + 1]); mxb = max3f(mxb, s1[r + 2], s1[r + 3]); }
            mx = swap_max(fmaxf(mxa, mxb));
            upd = (first && act) || __any(mx > THR);
        }
        if (upd) {
            const float dl = first ? mx : fmaxf(mx, 0.f);
            alpha_o = __builtin_amdgcn_exp2f(-dl); resc = !first;
            mref += dl;
#pragma unroll
            for (int r = 0; r < 16; ++r) { s0[r] -= dl; s1[r] -= dl; }
            lsum *= alpha_o;
            if (!FOX) {
#pragma unroll
                for (int r = 0; r < 16; ++r) negm[r] = -mref;
            }
            first = false;
            needmax = __any(qb - mref > THR) != 0;
        }
        ATT_SB();
        f32x2v ps2 = {0.f, 0.f};
        ATT_MM(va, 0); ATT_VRD(va, 1); ATT_EXPCH(s0, 0, pf[0]); ATT_SB();
        ATT_MM(va, 1); ATT_VRD(va, 2); ATT_EXPCH(s0, 8, pf[1]); ATT_SB();
        ATT_MM(va, 2); ATT_VRD(va, 3); ATT_EXPCH(s1, 0, pf[2]); ATT_SB();
        ATT_MM(va, 3); ATT_EXPCH(s1, 8, pf[3]); ATT_SB();
        lsum += ps2.x + ps2.y;
        if (resc) {
#pragma unroll
            for (int cb = 0; cb < NCB; ++cb)
#pragma unroll
                for (int r = 0; r < 16; ++r) o[cb][r] *= alpha_o;
        }
        pbuf = buf;
        if (FOX && act) wmore = __any(ub - mref > ckfirst) != 0;
        bool cont = have_next;
        if (FOX) { if (lane == 0) flags[buf * 8 + wid] = wmore ? 1 : 0; }
        ATT_WAIT_BAR(have_next2);
        if (FOX && cont) { int any_ = 0;
#pragma unroll
            for (int w8 = 0; w8 < 8; ++w8) any_ |= flags[buf * 8 + w8];
            cont = rfl(any_) != 0; }
        if (!cont) break;
        t = tn; buf = nbuf;
    }
    u32x2 gpre[NCB][4];
#pragma unroll
    for (int cb = 0; cb < NCB; ++cb)
#pragma unroll
        for (int gq = 0; gq < 4; ++gq) gpre[cb][gq] = (u32x2){0u, 0u};
    if (FOX || stream == 0) {
        const bf16_t* gp_ = G + (rowb + qrow) * 512 + 128 * g + (FOX ? 64 * stream : 0) + 4 * hi;
#pragma unroll
        for (int cb = 0; cb < NCB; ++cb)
#pragma unroll
            for (int gq = 0; gq < 4; ++gq) gpre[cb][gq] = *(const u32x2*)(gp_ + 32 * cb + 8 * gq);
    }
    { LAS const unsigned char* vbp_ = lds + pbuf * 32768; s16x4 va[NCB][2];
        ATT_VRD(va, 0); ATT_SB();
        ATT_MM(va, 0); ATT_VRD(va, 1); ATT_SB();
        ATT_MM(va, 1); ATT_VRD(va, 2); ATT_SB();
        ATT_MM(va, 2); ATT_VRD(va, 3); ATT_SB();
        ATT_MM(va, 3); ATT_SB(); }
#undef ATT_SB
#undef ATT_VRD
#undef ATT_MM
#undef ATT_EXPCH
    if (!FOX) __syncthreads();
    lsum = swap_add(lsum);
    const float invl = 1.0f / lsum;
    int qrow_e = qrow; asm volatile("" : "+v"(qrow_e));
    const int grow_i = g_row(b, qrow_e);
    const size_t grow = (size_t)(grow_i < 0 ? MROWS - 1 : grow_i);
    if (FOX) {
        const int colb = 128 * g + 64 * stream;
#pragma unroll
        for (int cb = 0; cb < 2; ++cb)
#pragma unroll
            for (int gq = 0; gq < 4; ++gq) {
                const int d0 = 32 * cb + 8 * gq + 4 * hi;
                const u32x2 gt = gpre[cb][gq];
                float v0 = o[cb][4 * gq] * invl * bf2f((unsigned short)(gt.x & 0xffff)), v1 = o[cb][4 * gq + 1] * invl * bf2f((unsigned short)(gt.x >> 16));
                float v2 = o[cb][4 * gq + 2] * invl * bf2f((unsigned short)(gt.y & 0xffff)), v3 = o[cb][4 * gq + 3] * invl * bf2f((unsigned short)(gt.y >> 16));
                u32x2 w; w.x = pk2(v0, v1); w.y = pk2(v2, v3);
                *(u32x2*)(AO + grow * DM + 512 + colb + d0) = w;
            }
    } else {
        LAS float* xch = (LAS float*)(lds + ATT_XCH) + wq * 4096 + lane;
        if (stream == 1) {
#pragma unroll
            for (int cb = 0; cb < NCB; ++cb)
#pragma unroll
                for (int r = 0; r < 16; ++r) xch[(cb * 16 + r) * 64] = o[cb][r] * invl;
        }
        __syncthreads();
        if (stream == 0) {
            float ss = 0.f;
#pragma unroll
            for (int cb = 0; cb < NCB; ++cb)
#pragma unroll
                for (int r = 0; r < 16; ++r) { const float v = o[cb][r] * invl - lam * xch[(cb * 16 + r) * 64]; o[cb][r] = v; ss += v * v; }
            ss = swap_add(ss);
            const float rs = oml / sqrtf(ss * (1.0f / 128.0f) + 1e-5f);
#pragma unroll
            for (int cb = 0; cb < NCB; ++cb)
#pragma unroll
                for (int gq = 0; gq < 4; ++gq) {
                    const int d0 = 32 * cb + 8 * gq + 4 * hi;
                    const f32x4 sg = *(const f32x4*)(subln + d0);
                    const u32x2 gt = gpre[cb][gq];
                    float v0 = o[cb][4 * gq] * rs * sg[0] * bf2f((unsigned short)(gt.x & 0xffff)), v1 = o[cb][4 * gq + 1] * rs * sg[1] * bf2f((unsigned short)(gt.x >> 16));
                    float v2 = o[cb][4 * gq + 2] * rs * sg[2] * bf2f((unsigned short)(gt.y & 0xffff)), v3 = o[cb][4 * gq + 3] * rs * sg[3] * bf2f((unsigned short)(gt.y >> 16));
                    u32x2 w; w.x = pk2(v0, v1); w.y = pk2(v2, v3);
                    *(u32x2*)(AO + grow * DM + 128 * g + d0) = w;
                }
        }
    }
}

__device__ __forceinline__ void attn_phase(LAS unsigned char* lds, const Args& a, int layer, unsigned* counters) {
    const int tid = opaque_tid(), lane = tid & 63;
    const bf16_t* QALL = (const bf16_t*)(a.ws + WS_QALL); bf16_t* AO = (bf16_t*)(a.ws + WS_HN);
    float kinf8[8], kinfd4[4];
#pragma unroll
    for (int i = 0; i < 4; ++i) kinfd4[i] = __uint_as_float(__hip_atomic_load((unsigned*)(a.ws + WS_CTL) + CW_KINFD + layer * 4 + i, __ATOMIC_RELAXED, __HIP_MEMORY_SCOPE_AGENT));
#pragma unroll
    for (int i = 0; i < 8; ++i) kinf8[i] = __uint_as_float(__hip_atomic_load((unsigned*)(a.ws + WS_CTL) + CW_KINF + layer * 8 + i, __ATOMIC_RELAXED, __HIP_MEMORY_SCOPE_AGENT));
    const bf16_t* KD = (const bf16_t*)(a.ws + WS_KD); const bf16_t* VD = (const bf16_t*)(a.ws + WS_VD); const bf16_t* GD = (const bf16_t*)(a.ws + WS_GD);
    const bf16_t* KF = (const bf16_t*)(a.ws + WS_KF); const bf16_t* VF = (const bf16_t*)(a.ws + WS_VF); const bf16_t* GF = (const bf16_t*)(a.ws + WS_GF);
    const float* CF = (const float*)(a.ws + WS_CF);
    const float d1 = wave_sum(a.lq1[layer * 64 + lane] * a.lk1[layer * 64 + lane]), d2 = wave_sum(a.lq2[layer * 64 + lane] * a.lk2[layer * 64 + lane]);
    const float lam_init = a.lam_init[layer];
    const float lam = expf(d1) - expf(d2) + lam_init, oml = 1.0f - lam_init;
    volatile LAS int* uw = (volatile LAS int*)(lds + ATT_UNITW);
    const int myx = (int)(xb_xcc_id() & 7u);
    int qx = myx, tried = 0, ip = 0;
    if (tid == 0) ip = (int)atomicAdd(counters + 64 * qx, 1u);
    for (;;) {
        __syncthreads();
        if (tid == 0) {
            int got = -1, q = qx, tr = tried, i = ip;
            for (;;) { if (i < 260) { got = q * 260 + i; break; } q = (q + 1) & 7; ++tr; if (tr >= 8) break; i = (int)atomicAdd(counters + 64 * q, 1u); }
            uw[0] = got; uw[1] = q; uw[2] = tr;
        }
        __syncthreads();
        const int u = rfl(uw[0]); qx = rfl(uw[1]); tried = rfl(uw[2]);
        if (u < 0) break;
        if (tid == 0) ip = (int)atomicAdd(counters + 64 * qx, 1u);
        const int q = u / 260, i = u % 260;
        if (i < 130) { const int j = NBLK - 1 - (i >> 1), bh = q + 8 * (i & 1); attn_unit<false>(lds, bh >> 2, bh & 3, j, QALL, KD, VD, GD, CF, a.subln + layer * 128, lam, oml, 1.42f * kinfd4[bh & 3], AO); }
        else { const int v = i - 130; const int j = NBLK - 1 - (v >> 1), bh = q + 8 * (v & 1); const int g = bh & 3; const float kinf = fmaxf(kinf8[2 * g], kinf8[2 * g + 1]);
               attn_unit<true>(lds, bh >> 2, g, j, QALL, KF, VF, GF, CF, nullptr, 0.f, 0.f, kinf, AO); }
    }
}

__global__ void __launch_bounds__(512, 2) hymba_fwd(Args a) {
    extern __shared__ __attribute__((aligned(16))) unsigned char lds_raw[];
    LAS unsigned char* lds = (LAS unsigned char*)lds_raw;
    cg::grid_group grid = cg::this_grid();
    unsigned* ctl = (unsigned*)(a.ws + WS_CTL);
    const bf16_t* HN = (const bf16_t*)(a.ws + WS_HN);
    bf16_t* QALL = (bf16_t*)(a.ws + WS_QALL);
    if (threadIdx.x < 2) ((volatile LAS unsigned*)(lds + ATT_UNITW + 256))[threadIdx.x] = 0u;
    __syncthreads();
    const XcdBarrier bar = xcd_barrier_post(ctl + CW_BAR, (volatile LAS unsigned*)(lds + ATT_UNITW + 256));
    prologue_phase(lds, a);
    __syncthreads();
    for (int layer = 0; layer < DEPTH; ++layer) {
        norm_phase(lds, a, layer);
        if (layer == 0) grid.sync(); else xcd_barrier(bar);
        cumfix_phase(lds, a);
        {
            pg8::Gemm g{(const bf16_t*)(a.ws + WS_H), (const bf16_t*)(a.ws + WS_WIN) + (size_t)layer * NPROJ * DM, MROWS, NPROJ, DM};
            pg8::StaticOrder S; S.init(GTOK, NPROJ, (int)gridDim.x, (int)blockIdx.x);
            EpiInProj E{QALL, (bf16_t*)(a.ws + WS_KD), (bf16_t*)(a.ws + WS_VD), (bf16_t*)(a.ws + WS_GD), (bf16_t*)(a.ws + WS_KF), (bf16_t*)(a.ws + WS_VF), (bf16_t*)(a.ws + WS_GF),
                        (const float*)(a.ws + WS_ROPE), (const float*)(a.ws + WS_ROPE) + LP * 8, ctl + CW_KINF + layer * 8, ctl + CW_KINFD + layer * 4, (const float*)(a.ws + WS_RSTD)};
            pg8::gemm_phase<EpiInProj, pg8::StaticOrder, true, true>(lds, g, S, E);
            meta_inproj(lds, (const bf16_t*)(a.ws + WS_H), (const bf16_t*)(a.ws + WS_WIN) + (size_t)layer * NPROJ * DM, E);
        }
        xcd_barrier(bar);
        attn_phase(lds, a, layer, ctl + 64 * (1 + layer * 8));
        xcd_barrier(bar);
        {
            pg8::Gemm g{HN, (const bf16_t*)(a.ws + WS_WOUT) + (size_t)layer * DM * DM, MROWS, DM, DM};
            pg8::StaticOrder S; S.init(GTOK, DM, (int)gridDim.x, (int)blockIdx.x);
            EpiResid E{(bf16_t*)(a.ws + WS_Y)};
            pg8::gemm_phase<EpiResid, pg8::StaticOrder, true, true>(lds, g, S, E);
            meta_outproj(lds, HN, (const bf16_t*)(a.ws + WS_WOUT) + (size_t)layer * DM * DM, (bf16_t*)(a.ws + WS_Y));
        }
        xcd_barrier(bar);
    }
    final_phase(a);
}

extern "C" void kernel_launch(void* const* d_in, const int* in_sizes, int n_in, void* d_out, int out_size, void* d_ws, size_t ws_size, hipStream_t stream) {
    static int grid = 0;
    if (grid == 0) {
        if (n_in != 12 || ws_size < WS_END) { fprintf(stderr, "kernel_launch: bad inputs (n_in %d, ws %zu < %zu)\n", n_in, ws_size, (size_t)WS_END); grid = -1; return; }
        int dev = 0, cus = 0, per_cu = 0;
        hipGetDevice(&dev); hipDeviceGetAttribute(&cus, hipDeviceAttributeMultiprocessorCount, dev);
        if (hipFuncSetAttribute((const void*)hymba_fwd, hipFuncAttributeMaxDynamicSharedMemorySize, LDS_BYTES) != hipSuccess) { fprintf(stderr, "hipFuncSetAttribute failed\n"); grid = -1; return; }
        if (hipOccupancyMaxActiveBlocksPerMultiprocessor(&per_cu, (const void*)hymba_fwd, 512, LDS_BYTES) != hipSuccess || per_cu < 1) { fprintf(stderr, "occupancy query: %d\n", per_cu); per_cu = 1; }
        (void)hipGetLastError();
        grid = cus * per_cu;
    }
    if (grid < 0) return;
    (void)hipMemsetAsync((char*)d_ws + WS_CTL, 0, CTL_BYTES, stream);
    Args a{};
    a.x = (const float*)d_in[0]; a.meta = (const float*)d_in[1]; a.norm_gain = (const float*)d_in[2]; a.w_in = (const float*)d_in[3]; a.forget_bias = (const float*)d_in[4];
    a.lq1 = (const float*)d_in[5]; a.lk1 = (const float*)d_in[6]; a.lq2 = (const float*)d_in[7]; a.lk2 = (const float*)d_in[8]; a.subln = (const float*)d_in[9];
    a.w_out = (const float*)d_in[10]; a.final_gain = (const float*)d_in[11];
    a.out = (float*)d_out; a.ws = (unsigned char*)d_ws;
    for (int l = 0; l < 4; ++l) a.lam_init[l] = (float)(0.8 - 0.6 * exp(-0.3 * (double)l));
    for (int i = 0; i < 8; ++i) a.inv_freq[i] = (float)(1.0 / pow(500000.0, (double)(2 * i) / 16.0));
    void* args[] = {&a};
    hipError_t e = hipLaunchCooperativeKernel((const void*)hymba_fwd, dim3(grid), dim3(512), args, LDS_BYTES, stream);
    if (e != hipSuccess) fprintf(stderr, "cooperative launch failed: %s (grid %d)\n", hipGetErrorString(e), grid);
}
```

```cpp
#include <hip/hip_runtime.h>
#include <hip/hip_cooperative_groups.h>
#include <cstdio>
#include <cstdint>
#include <cmath>
namespace cg = cooperative_groups;
namespace pg8 {
#define PG8_LAS __attribute__((address_space(3)))
typedef unsigned short bf16_t;
typedef short bf16x8 __attribute__((ext_vector_type(8)));
typedef float f32x4 __attribute__((ext_vector_type(4)));
typedef unsigned u32x4 __attribute__((ext_vector_type(4)));
constexpr int BM = 256, BK = 64, HALF = 128, HTB = HALF * BK * 2  , STAGE_BYTES = 8 * HTB, NXCD = 8, WGM = 8;

__host__ __device__ __forceinline__ int lds_byte(int r, int c) { const int st = (r >> 4) * 2 + (c >> 5), rr = r & 15, cc = c & 31, ob = rr * 64 + cc * 2; return st * 1024 + (ob ^ (((ob >> 9) & 1) << 5)); }
__host__ __device__ __forceinline__ void stage_rc(int b, int& R, int& C) { const int st = b / 1024, sb = b % 1024, swz = sb ^ (((sb >> 9) & 1) << 5); R = (st >> 1) * 16 + swz / 64; C = (st & 1) * 32 + (swz % 64) / 2; }
__host__ __device__ __forceinline__ int perm32(int rho) { const int n = rho >> 4, i = rho & 15; return 8 * (i >> 2) + 4 * n + (i & 3); }

struct Unit { int pm, pn; };
struct Gemm { const bf16_t* A; const bf16_t* Bt; int M, N, K; };

struct StaticOrder {
    int nM, nN, nwg, G, c;
    __host__ __device__ void init(int M, int N, int G_, int c_) { nM = M / BM; nN = N / BM; nwg = nM * nN; G = G_; c = c_; }
    __host__ __device__ bool next(int i, Unit& u) const {
        const long L = (long)i * G + c; if (L >= nwg) return false;
        int wgid = (int)L; { const int q = nwg / NXCD, r = nwg % NXCD, xcd = wgid % NXCD, off = wgid / NXCD; wgid = (xcd < r ? xcd * (q + 1) : r * (q + 1) + (xcd - r) * q) + off; }
        const int nig = WGM * nN, gid = wgid / nig, fm = gid * WGM, gsz = (nM - fm) < WGM ? (nM - fm) : WGM;
        u.pm = fm + ((wgid % nig) % gsz); u.pn = (wgid % nig) / gsz; return true;
    }
    __device__ __forceinline__ void a_ready(const Unit&) const {}
    __device__ __forceinline__ void done(const Unit&) const {}
};

__device__ __forceinline__ unsigned cvt_pk_bf16(float lo, float hi) { unsigned r; asm volatile("v_cvt_pk_bf16_f32 %0, %1, %2" : "=v"(r) : "v"(lo), "v"(hi)); return r; }
typedef float f32x2 __attribute__((ext_vector_type(2)));
template <class Epi, class Sched, bool ALIGN_EPI = false, bool SP2 = false>
__device__ __forceinline__ void gemm_phase(PG8_LAS unsigned char* lds, const Gemm g, const Sched& S, const Epi& E) {
    int tid_ = threadIdx.x; asm volatile("" : "+v"(tid_));
    const int tid = tid_, wid = __builtin_amdgcn_readfirstlane(tid >> 6), lane = tid & 63, wr = wid >> 2, wc = wid & 3, fr = lane & 15, fq = lane >> 4;
    const int K = g.K, nt = K / BK;
    unsigned voffA[2], voffB[2];
#pragma unroll
    for (int i = 0; i < 2; ++i) { int R, C; stage_rc(tid * 16 + i * 8192, R, C); const int Rb = Epi::PERM ? ((R & ~31) + perm32(R & 31)) : R;
        voffA[i] = (unsigned)(R * K + C) * 2u; voffB[i] = (unsigned)(Rb * K + C) * 2u; }
    const size_t kstep = (size_t)(BK * 2);
    const size_t hstep = (size_t)HALF * K * 2;
    const size_t tstep = 2 * hstep;
    const unsigned ldsw = (unsigned)wid * 1024u;
    const int aoff = lds_byte(wr * 64 + fr, fq * 8), boff = lds_byte(wc * 32 + fr, fq * 8);
#define PG8_SA(b, h) (((b) * 2 + (h)) * HTB)
#define PG8_SB(b, h) ((4 + (b) * 2 + (h)) * HTB)
#define PG8_STAGE(bufoff, gbase, voff) do { _Pragma("unroll") for (int _i = 0; _i < 2; ++_i) \
        __builtin_amdgcn_global_load_lds((const unsigned*)((const char*)(gbase) + (voff)[_i]), (PG8_LAS unsigned*)(lds + (bufoff) + ldsw + _i * 8192), 16, 0, 0); } while (0)
#define PG8_LDA(dst, b, h) do { _Pragma("unroll") for (int m = 0; m < 4; ++m) _Pragma("unroll") for (int k = 0; k < 2; ++k) dst[m][k] = *(const PG8_LAS bf16x8*)(lds + PG8_SA(b, h) + aoff + m * 2048 + k * 1024); } while (0)
#define PG8_LDB(dst, b, h) do { _Pragma("unroll") for (int n = 0; n < 2; ++n) _Pragma("unroll") for (int k = 0; k < 2; ++k) dst[n][k] = *(const PG8_LAS bf16x8*)(lds + PG8_SB(b, h) + boff + n * 2048 + k * 1024); } while (0)
#define PG8_MMA(ai, bj, At, Bt) do { __builtin_amdgcn_s_setprio(1); _Pragma("unroll") for (int m = 0; m < 4; ++m) _Pragma("unroll") for (int n = 0; n < 2; ++n) _Pragma("unroll") for (int k = 0; k < 2; ++k) \
        acc[ai][bj][m][n] = __builtin_amdgcn_mfma_f32_16x16x32_bf16(Bt[n][k], At[m][k], acc[ai][bj][m][n], 0, 0, 0); __builtin_amdgcn_s_setprio(0); } while (0)
#define PG8_WAIT_V(n) asm volatile("s_waitcnt vmcnt(" #n ")" ::: "memory")
#define PG8_WAIT_L(n) asm volatile("s_waitcnt lgkmcnt(" #n ")" ::: "memory")
#define PG8_BAR __builtin_amdgcn_s_barrier()
#define PG8_SCHED __builtin_amdgcn_sched_barrier(0)
    Unit cur, nxt; int ui = 0;
    if (!S.next(0, cur)) return;
    f32x4 acc[2][2][4][2];
#pragma unroll
    for (int a = 0; a < 2; ++a)
#pragma unroll
        for (int b = 0; b < 2; ++b)
#pragma unroll
            for (int m = 0; m < 4; ++m)
#pragma unroll
                for (int n = 0; n < 2; ++n) acc[a][b][m][n] = (f32x4){0.f, 0.f, 0.f, 0.f};
    bf16x8 At[4][2], B0[2][2], B1[2][2];
    const char* cA = (const char*)g.A + (size_t)cur.pm * tstep; const char* cB = (const char*)g.Bt + (size_t)cur.pn * tstep;
    S.a_ready(cur);
    if constexpr (SP2) {
        PG8_STAGE(PG8_SB(0, 0), cB, voffB); PG8_STAGE(PG8_SB(0, 1), cB + hstep, voffB); PG8_STAGE(PG8_SA(0, 0), cA, voffA); PG8_STAGE(PG8_SA(0, 1), cA + hstep, voffA);
        if (wr == 1) PG8_BAR;
        PG8_WAIT_V(2); PG8_BAR;
        PG8_STAGE(PG8_SB(1, 0), cB + kstep, voffB); PG8_STAGE(PG8_SA(1, 0), cA + kstep, voffA); PG8_STAGE(PG8_SB(1, 1), cB + hstep + kstep, voffB);
        PG8_WAIT_V(6); PG8_BAR;
    } else {
        PG8_STAGE(PG8_SB(0, 0), cB, voffB); PG8_STAGE(PG8_SA(0, 0), cA, voffA); PG8_STAGE(PG8_SB(0, 1), cB + hstep, voffB); PG8_STAGE(PG8_SA(0, 1), cA + hstep, voffA);
        if (wr == 1) PG8_BAR;
        PG8_WAIT_V(4); PG8_BAR;
        PG8_STAGE(PG8_SB(1, 0), cB + kstep, voffB); PG8_STAGE(PG8_SA(1, 0), cA + kstep, voffA); PG8_STAGE(PG8_SB(1, 1), cB + hstep + kstep, voffB);
        PG8_WAIT_V(6); PG8_BAR;
    }
    for (;;) {
        const bool has_next = S.next(ui + 1, nxt);
        const char* nA = has_next ? (const char*)g.A + (size_t)nxt.pm * tstep : cA; const char* nB = has_next ? (const char*)g.Bt + (size_t)nxt.pn * tstep : cB;
        for (int t = 0; t < nt; t += 2) {
            const bool last = (t == nt - 2);
            const char* a1 = cA + (size_t)(t + 1) * kstep;
            const char* a2 = last ? nA : cA + (size_t)(t + 2) * kstep; const char* b2 = last ? nB : cB + (size_t)(t + 2) * kstep;
            const char* a3 = a2 + kstep; const char* b3 = b2 + kstep;
            if (last && has_next) S.a_ready(nxt);
            if constexpr (SP2) {
            PG8_LDB(B0, 0, 0); PG8_LDB(B1, 0, 1); PG8_SCHED; PG8_LDA(At, 0, 0); PG8_STAGE(PG8_SA(1, 1), a1 + hstep, voffA);
            PG8_WAIT_V(8); PG8_WAIT_L(0); PG8_BAR; PG8_MMA(0, 0, At, B0); PG8_MMA(0, 1, At, B1); PG8_BAR; PG8_SCHED;
            PG8_LDA(At, 0, 1); PG8_STAGE(PG8_SB(0, 0), b2, voffB); PG8_STAGE(PG8_SB(0, 1), b2 + hstep, voffB); PG8_STAGE(PG8_SA(0, 0), a2, voffA);
            PG8_WAIT_V(8); PG8_WAIT_L(0); PG8_BAR; PG8_MMA(1, 0, At, B0); PG8_MMA(1, 1, At, B1); PG8_BAR; PG8_SCHED;
            PG8_LDB(B0, 1, 0); PG8_LDB(B1, 1, 1); PG8_SCHED; PG8_LDA(At, 1, 0); PG8_STAGE(PG8_SA(0, 1), a2 + hstep, voffA);
            PG8_WAIT_V(8); PG8_WAIT_L(0); PG8_BAR; PG8_MMA(0, 0, At, B0); PG8_MMA(0, 1, At, B1); PG8_BAR; PG8_SCHED;
            PG8_LDA(At, 1, 1); PG8_STAGE(PG8_SB(1, 0), b3, voffB); PG8_STAGE(PG8_SB(1, 1), b3 + hstep, voffB); PG8_STAGE(PG8_SA(1, 0), a3, voffA);
            PG8_WAIT_V(8); PG8_WAIT_L(0); PG8_BAR; PG8_MMA(1, 0, At, B0); PG8_MMA(1, 1, At, B1); PG8_BAR; PG8_SCHED;
            } else {
            PG8_LDB(B0, 0, 0); PG8_SCHED; PG8_LDA(At, 0, 0); PG8_STAGE(PG8_SA(1, 1), a1 + hstep, voffA);
            PG8_WAIT_L(8); PG8_BAR; PG8_WAIT_L(0); PG8_MMA(0, 0, At, B0); PG8_BAR; PG8_SCHED;
            PG8_LDB(B1, 0, 1); PG8_STAGE(PG8_SB(0, 0), b2, voffB);
            PG8_BAR; PG8_WAIT_L(0); PG8_MMA(0, 1, At, B1); PG8_BAR;
            PG8_LDA(At, 0, 1); PG8_STAGE(PG8_SA(0, 0), a2, voffA);
            PG8_BAR; PG8_WAIT_L(0); PG8_MMA(1, 0, At, B0); PG8_BAR; PG8_SCHED;
            PG8_STAGE(PG8_SB(0, 1), b2 + hstep, voffB);
            PG8_WAIT_V(6); PG8_BAR; PG8_MMA(1, 1, At, B1); PG8_BAR;
            PG8_LDB(B0, 1, 0); PG8_SCHED; PG8_LDA(At, 1, 0); PG8_STAGE(PG8_SA(0, 1), a2 + hstep, voffA);
            PG8_WAIT_L(8); PG8_BAR; PG8_WAIT_L(0); PG8_MMA(0, 0, At, B0); PG8_BAR; PG8_SCHED;
            PG8_LDB(B1, 1, 1); PG8_STAGE(PG8_SB(1, 0), b3, voffB);
            PG8_BAR; PG8_WAIT_L(0); PG8_MMA(0, 1, At, B1); PG8_BAR;
            PG8_LDA(At, 1, 1); PG8_STAGE(PG8_SA(1, 0), a3, voffA);
            PG8_BAR; PG8_WAIT_L(0); PG8_MMA(1, 0, At, B0); PG8_BAR; PG8_SCHED;
            PG8_STAGE(PG8_SB(1, 1), b3 + hstep, voffB);
            PG8_WAIT_V(6); PG8_BAR; PG8_MMA(1, 1, At, B1); PG8_BAR;
            }
        }
        if constexpr (ALIGN_EPI) { if (wr == 0) PG8_BAR; }
        if constexpr (!Epi::AFTER_DRAIN) { E(acc, cur, wr, wc, fr, fq); S.done(cur); }
        if (!has_next) break;
#pragma unroll
        for (int a = 0; a < 2; ++a)
#pragma unroll
            for (int b = 0; b < 2; ++b)
#pragma unroll
                for (int m = 0; m < 4; ++m)
#pragma unroll
                    for (int n = 0; n < 2; ++n) acc[a][b][m][n] = (f32x4){0.f, 0.f, 0.f, 0.f};
        cur = nxt; cA = nA; cB = nB; ++ui;
        if constexpr (ALIGN_EPI) { if (wr == 1) PG8_BAR; }
    }
    PG8_WAIT_V(0);
    if constexpr (!ALIGN_EPI) { if (wr == 0) PG8_BAR; }
    PG8_BAR;
    if constexpr (Epi::AFTER_DRAIN) { E.fused(acc, cur, wr, wc, fr, fq, lds, wid, lane); S.done(cur); }
#undef PG8_SA
#undef PG8_SB
#undef PG8_STAGE
#undef PG8_LDA
#undef PG8_LDB
#undef PG8_MMA
#undef PG8_WAIT_V
#undef PG8_WAIT_L
#undef PG8_BAR
#undef PG8_SCHED
}
}

#define LAS __attribute__((address_space(3)))
typedef unsigned short bf16_t;
typedef short bf16x8 __attribute__((ext_vector_type(8)));
typedef short s16x4 __attribute__((ext_vector_type(4)));
typedef float f32x16 __attribute__((ext_vector_type(16)));
typedef float f32x4 __attribute__((ext_vector_type(4)));
typedef float f32x2v __attribute__((ext_vector_type(2)));
typedef unsigned u32x4 __attribute__((ext_vector_type(4)));
typedef unsigned u32x2 __attribute__((ext_vector_type(2)));
typedef __bf16 bf16x2_t __attribute__((ext_vector_type(2)));

constexpr int NB = 4, SEQ = 8192, NMETA = 16, DM = 1024, DEPTH = 4;
constexpr int LP = 8320, PADF = 112;
constexpr int MROWS = NB * LP;
constexpr int DIN = 4104, NPROJ = 4096, FFCOL = 3584;
constexpr int NSEG = 256, SEGROWS = 130;
constexpr float LOG2E = 1.4426950408889634f;
constexpr float QSCALE = 0.125f * LOG2E;
constexpr int NBLK = 65;
constexpr int NUNIT_HALF = 16 * NBLK;
constexpr int LDS_BYTES = 147456;

constexpr size_t WS_CTL = 0, CTL_BYTES = 32768;
constexpr int CW_KINF = 16, CW_KINFD = 48, CW_BAR = 4096;
constexpr size_t WS_ROPE = 32768;
constexpr size_t WS_CL = WS_ROPE + (size_t)2 * LP * 8 * 4;
constexpr size_t WS_CF = WS_CL + (size_t)MROWS * 8 * 4;
constexpr size_t WS_TOT = WS_CF + (size_t)MROWS * 8 * 4;
constexpr size_t WS_WIN = (size_t)4 << 20;
constexpr size_t WS_WOUT = WS_WIN + (size_t)DEPTH * NPROJ * DM * 2;
constexpr size_t WS_H = WS_WOUT + (size_t)DEPTH * DM * DM * 2;
constexpr size_t WS_HN = WS_H + (size_t)MROWS * DM * 4;
constexpr size_t WS_QALL = WS_HN + (size_t)MROWS * DM * 2;
constexpr size_t SZ512 = (size_t)MROWS * 512 * 2;
constexpr size_t WS_KD = WS_QALL + (size_t)MROWS * DM * 2;
constexpr size_t WS_VD = WS_KD + SZ512, WS_GD = WS_VD + SZ512, WS_KF = WS_GD + SZ512, WS_VF = WS_KF + SZ512, WS_GF = WS_VF + SZ512;
constexpr size_t WS_END = WS_GF + SZ512;
constexpr size_t WS_Y = WS_KD;
static_assert(WS_Y + (size_t)MROWS * DM * 4 <= WS_END, "y overlay");
constexpr size_t WS_RSTD = WS_TOT + 256 * 8 * 4;
static_assert(WS_RSTD + (size_t)MROWS * 4 <= WS_WIN, "ws map");

struct Args {
    const float* x; const float* meta; const float* norm_gain; const float* w_in; const float* forget_bias;
    const float* lq1; const float* lk1; const float* lq2; const float* lk2; const float* subln; const float* w_out; const float* final_gain;
    float* out; unsigned char* ws;
    float lam_init[4]; float inv_freq[8];
};

__device__ __forceinline__ int rfl(int v) { return __builtin_amdgcn_readfirstlane(v); }
__device__ __forceinline__ int opaque_tid() { int t = threadIdx.x; asm volatile("" : "+v"(t)); return t; }
__device__ __forceinline__ float wave_sum(float v) {
#pragma unroll
    for (int o = 1; o < 64; o <<= 1) v += __shfl_xor(v, o);
    return v;
}
__device__ __forceinline__ unsigned f2bf(float f) { unsigned u = __builtin_bit_cast(unsigned, f); return (u + 0x7fffu + ((u >> 16) & 1u)) >> 16; }
__device__ __forceinline__ unsigned pk2(float lo, float hi) { f32x2v v = {lo, hi}; bf16x2_t b = __builtin_convertvector(v, bf16x2_t); return __builtin_bit_cast(unsigned, b); }
__device__ __forceinline__ float bf2f(unsigned short u) { return __builtin_bit_cast(float, (unsigned)u << 16); }
__device__ __forceinline__ float swap_max(float m) { auto rr = __builtin_amdgcn_permlane32_swap(__float_as_uint(m), __float_as_uint(m), false, false); return fmaxf(__uint_as_float(rr[0]), __uint_as_float(rr[1])); }
__device__ __forceinline__ float swap_add(float m) { auto rr = __builtin_amdgcn_permlane32_swap(__float_as_uint(m), __float_as_uint(m), false, false); return __uint_as_float(rr[0]) + __uint_as_float(rr[1]); }

__device__ __forceinline__ float fadd_s(float a, float b) { float r; asm("v_add_f32_e32 %0, %1, %2" : "=v"(r) : "v"(a), "v"(b)); return r; }
__device__ __forceinline__ float max3f(float a, float b, float c) { float r; asm("v_max3_f32 %0, %1, %2, %3" : "=v"(r) : "v"(a), "v"(b), "v"(c)); return r; }

struct EpiInProj {
    static constexpr bool PERM = true, AFTER_DRAIN = false;
    bf16_t* qall; bf16_t* kd; bf16_t* vd; bf16_t* gd; bf16_t* kf; bf16_t* vf; bf16_t* gf; const float* ropec; const float* ropes; unsigned* kinf; unsigned* kinfd; const float* rstd;
    __device__ __forceinline__ void operator()(const pg8::f32x4 (&acc)[2][2][4][2], const pg8::Unit& u, int wr, int wc, int fr, int fq) const {
        const int type = u.pn >> 1, half = u.pn & 1;
        bf16_t* base; int ldc = 512; float sc = 1.f; bool rope = false, silu = false;
        switch (type) {
            case 0: base = qall; ldc = 1024; sc = QSCALE; rope = true; break;
            case 1: base = kd; rope = true; break;
            case 2: base = vd; break;
            case 3: base = gd; silu = true; break;
            case 4: base = qall + 512; ldc = 1024; sc = QSCALE; break;
            case 5: base = kf; break;
            case 6: base = vf; break;
            default: base = gf; silu = true; break;
        }
        base += 256 * half;
        if (type == 5 || type == 1) {
#pragma unroll
            for (int bj = 0; bj < 2; ++bj) { float mxa = 0.f;
#pragma unroll
                for (int ai = 0; ai < 2; ++ai)
#pragma unroll
                    for (int m = 0; m < 4; ++m)
#pragma unroll
                        for (int n = 0; n < 2; ++n)
#pragma unroll
                            for (int e = 0; e < 4; ++e) mxa = fmaxf(mxa, fabsf(acc[ai][bj][m][n][e]) * rstd[u.pm * 256 + wr * 64 + fr + ai * 128 + m * 16]);
#pragma unroll
                for (int o = 1; o < 64; o <<= 1) mxa = fmaxf(mxa, __shfl_xor(mxa, o));
                if (fr == 0 && fq == 0) atomicMax(type == 5 ? kinf + 4 * half + 2 * bj + (wc >> 1) : kinfd + 2 * half + bj, __float_as_uint(mxa)); }
        }
        const int row0 = u.pm * 256 + wr * 64 + fr, col0 = wc * 32 + 8 * fq;
        const bool dorope = rope && ((wc & 1) == 0);
        const float sgn = (fq == 0) ? -1.f : 1.f;
#pragma unroll
        for (int ai = 0; ai < 2; ++ai)
#pragma unroll
            for (int m = 0; m < 4; ++m) {
                const int row = row0 + ai * 128 + m * 16;
                const int tok = row & (SEQ - 1);
                bf16_t* rowp = base + (size_t)((row >> 13) * LP + PADF + NMETA + tok) * ldc + col0;
                const float scr = sc * rstd[row];
                f32x4 c0 = {1.f, 1.f, 1.f, 1.f}, c1 = c0, s0 = {0.f, 0.f, 0.f, 0.f}, s1 = s0;
                if (dorope) {
                    const int pos = NMETA + tok;
                    if (fq < 2) { c0 = *(const f32x4*)(ropec + pos * 8); c1 = *(const f32x4*)(ropec + pos * 8 + 4); s0 = *(const f32x4*)(ropes + pos * 8); s1 = *(const f32x4*)(ropes + pos * 8 + 4); }
                }
#pragma unroll
                for (int bj = 0; bj < 2; ++bj) {
                    f32x4 v0 = acc[ai][bj][m][0] * scr, v1 = acc[ai][bj][m][1] * scr;
                    if (dorope) {
                        f32x4 p0, p1;
#pragma unroll
                        for (int e = 0; e < 4; ++e) { p0[e] = __shfl_xor(v0[e], 16); p1[e] = __shfl_xor(v1[e], 16); }
                        v0 = v0 * c0 + (p0 * s0) * sgn; v1 = v1 * c1 + (p1 * s1) * sgn;
                    }
                    if (silu) {
#pragma unroll
                        for (int e = 0; e < 4; ++e) { v0[e] = v0[e] * __builtin_amdgcn_rcpf(1.f + __builtin_amdgcn_exp2f(-LOG2E * v0[e])); v1[e] = v1[e] * __builtin_amdgcn_rcpf(1.f + __builtin_amdgcn_exp2f(-LOG2E * v1[e])); }
                    }
                    u32x4 w; w.x = pk2(v0[0], v0[1]); w.y = pk2(v0[2], v0[3]); w.z = pk2(v1[0], v1[1]); w.w = pk2(v1[2], v1[3]);
                    *(u32x4*)(rowp + bj * 128) = w;
                }
            }
    }
};
struct EpiResid {
    static constexpr bool PERM = true, AFTER_DRAIN = false;
    bf16_t* y;
    __device__ __forceinline__ void operator()(const pg8::f32x4 (&acc)[2][2][4][2], const pg8::Unit& u, int wr, int wc, int fr, int fq) const {
        const int row0 = u.pm * 256 + wr * 64 + fr, col0 = u.pn * 256 + wc * 32 + 8 * fq;
#pragma unroll
        for (int ai = 0; ai < 2; ++ai)
#pragma unroll
            for (int m = 0; m < 4; ++m) {
                bf16_t* rp = y + (size_t)(row0 + ai * 128 + m * 16) * DM + col0;
#pragma unroll
                for (int bj = 0; bj < 2; ++bj) { const f32x4 v0 = acc[ai][bj][m][0], v1 = acc[ai][bj][m][1];
                    u32x4 w; w.x = pk2(v0[0], v0[1]); w.y = pk2(v0[2], v0[3]); w.z = pk2(v1[0], v1[1]); w.w = pk2(v1[2], v1[3]);
                    *(u32x4*)(rp + bj * 128) = w; }
            }
    }
};

constexpr int GTOK = NB * SEQ;
__device__ __forceinline__ int g_row(int b, int P) { return P >= PADF + NMETA ? b * SEQ + (P - PADF - NMETA) : (P >= PADF ? GTOK + b * NMETA + (P - PADF) : -1); }
__device__ __forceinline__ void meta_outproj(LAS unsigned char* lds, const bf16_t* __restrict__ AO, const bf16_t* __restrict__ Wt, bf16_t* __restrict__ Y) {
    const int tid = opaque_tid(), lane = tid & 63, wid = rfl(tid >> 6);
    typedef float f32x4m __attribute__((ext_vector_type(4)));
    LAS f32x4m* part = (LAS f32x4m*)lds;
    for (int blk = blockIdx.x; blk < 256; blk += gridDim.x) {
        const int rb = blk >> 6, cb = blk & 63;
        const bf16_t* ap = AO + (size_t)(GTOK + 16 * rb + (lane & 15)) * DM + 8 * (lane >> 4) + 128 * wid;
        const bf16_t* bp = Wt + (size_t)(16 * cb + (lane & 15)) * DM + 8 * (lane >> 4) + 128 * wid;
        f32x4m acc = {0.f, 0.f, 0.f, 0.f};
#pragma unroll
        for (int ks = 0; ks < 4; ++ks) { const bf16x8 av = *(const bf16x8*)(ap + 32 * ks), bv = *(const bf16x8*)(bp + 32 * ks); acc = __builtin_amdgcn_mfma_f32_16x16x32_bf16(av, bv, acc, 0, 0, 0); }
        part[wid * 64 + lane] = acc;
        __syncthreads();
        if (wid == 0) {
            f32x4m t = part[lane];
#pragma unroll
            for (int w = 1; w < 8; ++w) t = t + part[w * 64 + lane];
#pragma unroll
            for (int r = 0; r < 4; ++r) Y[(size_t)(GTOK + 16 * rb + 4 * (lane >> 4) + r) * DM + 16 * cb + (lane & 15)] = (bf16_t)(pk2(t[r], 0.f) & 0xffffu);
        }
        __syncthreads();
    }
}

__device__ __forceinline__ void meta_inproj(LAS unsigned char* lds, const bf16_t* __restrict__ H, const bf16_t* __restrict__ Wt, const EpiInProj& E) {
    const int tid = opaque_tid(), lane = tid & 63, wid = rfl(tid >> 6), blkl = wid >> 1, kh = wid & 1;
    typedef float f32x4m __attribute__((ext_vector_type(4)));
    LAS f32x4m* part = (LAS f32x4m*)lds;
    for (int base = blockIdx.x * 4; base < 1024; base += gridDim.x * 4) {
        const int blk = base + blkl, rb = blk >> 8, cb = blk & 255;
        const bf16_t* ap = H + (size_t)(GTOK + 16 * rb + (lane & 15)) * DM + 8 * (lane >> 4) + 512 * kh;
        const bf16_t* bp = Wt + (size_t)(16 * cb + (lane & 15)) * DM + 8 * (lane >> 4) + 512 * kh;
        f32x4m acc = {0.f, 0.f, 0.f, 0.f};
#pragma unroll 4
        for (int ks = 0; ks < 16; ++ks) { const bf16x8 av = *(const bf16x8*)(ap + 32 * ks), bv = *(const bf16x8*)(bp + 32 * ks); acc = __builtin_amdgcn_mfma_f32_16x16x32_bf16(av, bv, acc, 0, 0, 0); }
        part[wid * 64 + lane] = acc;
        __syncthreads();
        if (kh == 0) {
            const f32x4m t = part[wid * 64 + lane] + part[(wid + 1) * 64 + lane];
            const int n = 16 * cb + (lane & 15), type = n >> 9, cw = n & 511, i0 = 4 * (lane >> 4);
            const bool ropeblk = (type < 2) && ((cb & 3) == 0);
            const float sc = (type == 0 || type == 4) ? QSCALE : 1.f;
            float v[4], mxa = 0.f;
#pragma unroll
            for (int r = 0; r < 4; ++r) { const float kv = t[r] * E.rstd[GTOK + 16 * rb + i0 + r]; mxa = fmaxf(mxa, fabsf(kv)); v[r] = kv * sc; }
            if (type == 1 || type == 5) {
#pragma unroll
                for (int o = 1; o < 64; o <<= 1) mxa = fmaxf(mxa, __shfl_xor(mxa, o));
                const int cw0 = (16 * cb) & 511;
                if (lane == 0) atomicMax(type == 5 ? E.kinf + (cw0 >> 6) : E.kinfd + (cw0 >> 7), __float_as_uint(mxa));
            }
            if (ropeblk) {
                const int d = lane & 15;
#pragma unroll
                for (int r = 0; r < 4; ++r) { const float p = __shfl_xor(v[r], 8); const float c = E.ropec[(i0 + r) * 8 + (d & 7)], sn = E.ropes[(i0 + r) * 8 + (d & 7)]; v[r] = v[r] * c + (d < 8 ? -p : p) * sn; }
            }
            if (type == 3 || type == 7) {
#pragma unroll
                for (int r = 0; r < 4; ++r) v[r] = v[r] * __builtin_amdgcn_rcpf(1.f + __builtin_amdgcn_exp2f(-LOG2E * v[r]));
            }
            bf16_t* dst; int ldc = 512;
            switch (type) { case 0: dst = E.qall; ldc = 1024; break; case 1: dst = E.kd; break; case 2: dst = E.vd; break; case 3: dst = E.gd; break;
                            case 4: dst = E.qall + 512; ldc = 1024; break; case 5: dst = E.kf; break; case 6: dst = E.vf; break; default: dst = E.gf; break; }
#pragma unroll
            for (int r = 0; r < 4; ++r) dst[(size_t)(rb * LP + PADF + i0 + r) * ldc + cw] = (bf16_t)(pk2(v[r], 0.f) & 0xffffu);
        }
        __syncthreads();
    }
}

__device__ __forceinline__ void transpose_item(const float* W, int ldw, int K, bf16_t* WT, LAS float* scr, int kb, int nb, int srccol0, int lane, const float* gk) {
    const int k0 = 64 * kb, n0 = 32 * nb;
#pragma unroll 8
    for (int i = 0; i < 32; ++i) { const int kk = 2 * i + (lane >> 5); scr[kk * 33 + (lane & 31)] = W[(size_t)(k0 + kk) * ldw + srccol0 + (lane & 31)] * (gk ? gk[k0 + kk] : 1.0f); }
    asm volatile("s_waitcnt lgkmcnt(0)" ::: "memory");
    const int c = lane & 7;
#pragma unroll
    for (int j = 0; j < 4; ++j) { const int n = (lane >> 3) + 8 * j; const LAS float* s = scr + (8 * c) * 33 + n;
        u32x4 o; o.x = pk2(s[0 * 33], s[1 * 33]); o.y = pk2(s[2 * 33], s[3 * 33]); o.z = pk2(s[4 * 33], s[5 * 33]); o.w = pk2(s[6 * 33], s[7 * 33]);
        *(u32x4*)(WT + (size_t)(n0 + n) * K + k0 + 8 * c) = o; }
    asm volatile("s_waitcnt lgkmcnt(0)" ::: "memory");
}
__device__ __forceinline__ void prologue_phase(LAS unsigned char* lds, const Args& a) {
    const int tid = opaque_tid(), lane = tid & 63, wid = rfl(tid >> 6);
    LAS float* scr = (LAS float*)(lds + wid * 8448);
    const int gw = blockIdx.x * 8 + wid, NGW = gridDim.x * 8;
    constexpr int I_IN = 16 * 128, I_OUT = 16 * 32, I_L = I_IN + I_OUT;
    bf16_t* WIN = (bf16_t*)(a.ws + WS_WIN); bf16_t* WOUT = (bf16_t*)(a.ws + WS_WOUT);
    for (int it = gw; it < DEPTH * I_L; it += NGW) {
        const int l = it / I_L; int r = it % I_L;
        if (r < I_IN) { const int kb = r / 128, nb = r % 128; const int n0 = 32 * nb; const int src = n0 < FFCOL ? n0 : n0 + 8;
            transpose_item(a.w_in + (size_t)l * DM * DIN, DIN, DM, WIN + (size_t)l * NPROJ * DM, scr, kb, nb, src, lane, a.norm_gain + l * DM); }
        else { r -= I_IN; const int kb = r / 32, nb = r % 32;
            transpose_item(a.w_out + (size_t)l * DM * DM, DM, DM, WOUT + (size_t)l * DM * DM, scr, kb, nb, 32 * nb, lane, nullptr); }
    }
    float* rc = (float*)(a.ws + WS_ROPE); float* rs = rc + LP * 8;
    for (int i = blockIdx.x * 512 + tid; i < LP * 8; i += gridDim.x * 512) {
        const int pos = i >> 3, f = i & 7;
        const float ang = (float)pos * a.inv_freq[f];
        double rev = (double)ang * 0.15915494309189533577; rev -= floor(rev);
        rc[i] = __builtin_amdgcn_cosf((float)rev); rs[i] = __builtin_amdgcn_sinf((float)rev);
    }
}

__device__ __forceinline__ float dppf(float v, const int ctrl_sel) {
    const int x = __float_as_int(v); int r;
    if (ctrl_sel == 0) r = __builtin_amdgcn_update_dpp(x, x, 0xB1, 0xF, 0xF, true);
    else if (ctrl_sel == 1) r = __builtin_amdgcn_update_dpp(x, x, 0x4E, 0xF, 0xF, true);
    else if (ctrl_sel == 2) r = __builtin_amdgcn_update_dpp(x, x, 0x141, 0xF, 0xF, true);
    else r = __builtin_amdgcn_update_dpp(x, x, 0x140, 0xF, 0xF, true);
    return __int_as_float(r);
}
__device__ __forceinline__ float wsum(float v) {
    v += dppf(v, 0); v += dppf(v, 1); v += dppf(v, 2); v += dppf(v, 3);
    { auto rr = __builtin_amdgcn_permlane16_swap(__float_as_uint(v), __float_as_uint(v), false, false); v = __uint_as_float(rr[0]) + __uint_as_float(rr[1]); }
    return swap_add(v);
}
__device__ __forceinline__ void norm_phase(LAS unsigned char* lds, const Args& a, int layer) {
    const int tid = opaque_tid(), lane = tid & 63, wid = rfl(tid >> 6);
    LAS float* lf = (LAS float*)lds;
    bf16_t* H = (bf16_t*)(a.ws + WS_H); const bf16_t* Y = (const bf16_t*)(a.ws + WS_Y); float* RSTD = (float*)(a.ws + WS_RSTD); float* CL = (float*)(a.ws + WS_CL); float* TOT = (float*)(a.ws + WS_TOT);
    const float* gain = a.norm_gain + layer * DM;
    const float* wff = a.w_in + (size_t)layer * DM * DIN + FFCOL;
    LAS f32x4* wl = (LAS f32x4*)(lds + 8192);
    for (int k = tid; k < DM; k += 512) { const float gk = gain[k]; const float* p = wff + (size_t)k * DIN; const int jj = k >> 8, ln = (k & 255) >> 2, e = k & 3;
        wl[((jj * 4 + e) * 2 + 0) * 64 + ln] = *(const f32x4*)p * gk; wl[((jj * 4 + e) * 2 + 1) * 64 + ln] = *(const f32x4*)(p + 4) * gk; }
    __syncthreads();
    const float fb = a.forget_bias[layer * 8 + (lane & 7)];
    for (int seg = blockIdx.x; seg < NSEG; seg += gridDim.x) {
        const int row0 = seg * SEGROWS;
        f32x4 nh[4], ny[4];
#define NORM_LOAD(r_) do { const int row_ = row0 + (r_), b_ = row_ / LP, P_ = row_ % LP; \
            if (layer == 0) { \
                if (P_ < PADF) { _Pragma("unroll") for (int jj = 0; jj < 4; ++jj) nh[jj] = (f32x4){0.f, 0.f, 0.f, 0.f}; } \
                else { const float* src_ = (P_ < PADF + NMETA) ? a.meta + (size_t)(P_ - PADF) * DM : a.x + ((size_t)b_ * SEQ + (P_ - PADF - NMETA)) * DM; \
                    _Pragma("unroll") for (int jj = 0; jj < 4; ++jj) nh[jj] = *(const f32x4*)(src_ + 256 * jj + 4 * lane); } \
                _Pragma("unroll") for (int jj = 0; jj < 4; ++jj) ny[jj] = (f32x4){0.f, 0.f, 0.f, 0.f}; \
            } else { \
                const int gr_ = g_row(b_, P_); const size_t yr_ = (size_t)(gr_ < 0 ? 0 : gr_); \
                _Pragma("unroll") for (int jj = 0; jj < 4; ++jj) { u32x2 hb_ = *(const u32x2*)(H + yr_ * DM + 256 * jj + 4 * lane); u32x2 yb_ = *(const u32x2*)(Y + yr_ * DM + 256 * jj + 4 * lane); if (gr_ < 0) { hb_ = (u32x2){0u, 0u}; yb_ = hb_; } \
                    nh[jj] = (f32x4){__uint_as_float(hb_.x << 16), __uint_as_float(hb_.x & 0xffff0000u), __uint_as_float(hb_.y << 16), __uint_as_float(hb_.y & 0xffff0000u)}; \
                    ny[jj] = (f32x4){__uint_as_float(yb_.x << 16), __uint_as_float(yb_.x & 0xffff0000u), __uint_as_float(yb_.y << 16), __uint_as_float(yb_.y & 0xffff0000u)}; } \
            } } while (0)
        NORM_LOAD(wid);
        for (int r = wid; r < SEGROWS; r += 8) {
            const int row = row0 + r, P = row % LP, grw = g_row(row / LP, P);
            f32x4 v[4];
#pragma unroll
            for (int jj = 0; jj < 4; ++jj) v[jj] = nh[jj] + ny[jj];
            if (r + 8 < SEGROWS) NORM_LOAD(r + 8);
#pragma unroll
            for (int jj = 0; jj < 4; ++jj) { u32x2 o; o.x = pk2(v[jj].x, v[jj].y); o.y = pk2(v[jj].z, v[jj].w); if (grw >= 0) *(u32x2*)(H + (size_t)grw * DM + 256 * jj + 4 * lane) = o; }
            float ss = 0.f, acc[8];
#pragma unroll
            for (int c = 0; c < 8; ++c) acc[c] = 0.f;
#pragma unroll
            for (int jj = 0; jj < 4; ++jj) {
                ss += (v[jj].x * v[jj].x + v[jj].y * v[jj].y) + (v[jj].z * v[jj].z + v[jj].w * v[jj].w);
#pragma unroll
                for (int e = 0; e < 4; ++e) { const float xv = v[jj][e]; const f32x4 w0 = wl[((jj * 4 + e) * 2 + 0) * 64 + lane], w1 = wl[((jj * 4 + e) * 2 + 1) * 64 + lane];
#pragma unroll
                    for (int c = 0; c < 4; ++c) { acc[c] += xv * w0[c]; acc[4 + c] += xv * w1[c]; } }
            }
            ss = wsum(ss);
#pragma unroll
            for (int c = 0; c < 8; ++c) acc[c] = wsum(acc[c]);
            const float rstd = 1.0f / sqrtf(ss * (1.0f / DM) + 1e-6f);
            if (lane == 0 && grw >= 0) RSTD[grw] = rstd;
            const int lc = lane & 7;
            float z = lc == 0 ? acc[0] : lc == 1 ? acc[1] : lc == 2 ? acc[2] : lc == 3 ? acc[3] : lc == 4 ? acc[4] : lc == 5 ? acc[5] : lc == 6 ? acc[6] : acc[7];
            z = z * rstd + fb;
            float lfv = fminf(z, 0.f) - log1pf(expf(-fabsf(z)));
            if (P < PADF) lfv = 0.f;
            if (lane < 8) lf[r * 8 + lane] = lfv;
        }
#undef NORM_LOAD
        __syncthreads();
        if (wid == 0) {
            const int c = lane & 7, ch = lane >> 3;
            float vals[17], s = 0.f;
#pragma unroll
            for (int i = 0; i < 17; ++i) { const int r = ch * 17 + i; s += (r < SEGROWS) ? lf[r * 8 + c] : 0.f; vals[i] = s; }
            lf[1152 + lane] = s;
            asm volatile("s_waitcnt lgkmcnt(0)" ::: "memory");
            float off = 0.f;
#pragma unroll
            for (int k = 0; k < 7; ++k) off += (k < ch) ? lf[1152 + k * 8 + c] : 0.f;
#pragma unroll
            for (int i = 0; i < 17; ++i) { const int r = ch * 17 + i; if (r < SEGROWS) CL[(size_t)(row0 + r) * 8 + c] = vals[i] + off; }
            if (ch == 7) TOT[seg * 8 + c] = vals[16] + off;
        }
        __syncthreads();
    }
}
__device__ __forceinline__ void cumfix_phase(LAS unsigned char* lds, const Args& a) {
    const int tid = opaque_tid();
    LAS float* sc = (LAS float*)lds;
    const float* CL = (const float*)(a.ws + WS_CL); const float* TOT = (const float*)(a.ws + WS_TOT); float* CF = (float*)(a.ws + WS_CF);
    for (int seg = blockIdx.x; seg < NSEG; seg += gridDim.x) {
        const int b = seg >> 6, s = seg & 63, part = tid >> 3, c = tid & 7;
        sc[part * 8 + c] = (part < s) ? TOT[(b * 64 + part) * 8 + c] : 0.f;
        __syncthreads();
        if (tid < 8) { float t = 0.f; for (int p = 0; p < 64; ++p) t += sc[p * 8 + tid]; sc[512 + tid] = t; }
        __syncthreads();
        for (int i = tid; i < SEGROWS * 8; i += 512) CF[(size_t)seg * SEGROWS * 8 + i] = CL[(size_t)seg * SEGROWS * 8 + i] + sc[512 + (i & 7)];
        __syncthreads();
    }
}
__device__ __forceinline__ void final_phase(const Args& a) {
    const int tid = opaque_tid(), lane = tid & 63, wid = rfl(tid >> 6);
    const bf16_t* H = (const bf16_t*)(a.ws + WS_H); const bf16_t* Y = (const bf16_t*)(a.ws + WS_Y);
    f32x4 g4[4];
#pragma unroll
    for (int jj = 0; jj < 4; ++jj) g4[jj] = *(const f32x4*)(a.final_gain + 256 * jj + 4 * lane);
    for (int orow = blockIdx.x * 8 + wid; orow < NB * SEQ; orow += gridDim.x * 8) {
        const int b = orow / SEQ, s = orow % SEQ; const size_t row = (size_t)b * LP + PADF + NMETA + s;
        f32x4 v[4]; float ss = 0.f;
#pragma unroll
        for (int jj = 0; jj < 4; ++jj) { const u32x2 yb_ = *(const u32x2*)(Y + (size_t)orow * DM + 256 * jj + 4 * lane); const u32x2 hb_ = *(const u32x2*)(H + (size_t)orow * DM + 256 * jj + 4 * lane); v[jj] = (f32x4){__uint_as_float(hb_.x << 16), __uint_as_float(hb_.x & 0xffff0000u), __uint_as_float(hb_.y << 16), __uint_as_float(hb_.y & 0xffff0000u)} + (f32x4){__uint_as_float(yb_.x << 16), __uint_as_float(yb_.x & 0xffff0000u), __uint_as_float(yb_.y << 16), __uint_as_float(yb_.y & 0xffff0000u)}; ss += (v[jj].x * v[jj].x + v[jj].y * v[jj].y) + (v[jj].z * v[jj].z + v[jj].w * v[jj].w); }
        ss = wsum(ss);
        const float rstd = 1.0f / sqrtf(ss * (1.0f / DM) + 1e-6f);
#pragma unroll
        for (int jj = 0; jj < 4; ++jj) *(f32x4*)(a.out + (size_t)orow * DM + 256 * jj + 4 * lane) = v[jj] * rstd * g4[jj];
    }
}

#define XB_TMO      128
#define XB_XCNT(j)  (256  + 64 * (j))
#define XB_XSUB(j)  (1280 + 64 * (j))
#define XB_XGEN(j)  (2304 + 64 * (j))
#define XB_TOP      3328
#define XB_TOPGEN   3392
#define XCD_BAR_WORDS 3456
#define XB_SPIN_CAP (1u << 18)

__device__ __forceinline__ unsigned xb_ld(unsigned* p)              { return __hip_atomic_load(p, __ATOMIC_RELAXED, __HIP_MEMORY_SCOPE_AGENT); }
__device__ __forceinline__ unsigned xb_add(unsigned* p, unsigned v) { return __hip_atomic_fetch_add(p, v, __ATOMIC_RELAXED, __HIP_MEMORY_SCOPE_AGENT); }
__device__ __forceinline__ unsigned xb_xcc_id() { return (unsigned)__builtin_amdgcn_s_getreg((3 << 11) | 20) & 0xFu; }
#define XB_SPIN(cond, bar) do { unsigned _sp = 0; while (cond) { __builtin_amdgcn_s_sleep(1); \
    if ((++_sp & 255u) == 0u) { if (xb_ld(&(bar)[XB_TMO])) break; if (_sp > XB_SPIN_CAP) { atomicAdd(&(bar)[XB_TMO], 1u); break; } } } } while (0)

struct XcdBarrier {
    unsigned* bar; unsigned x;
    volatile LAS unsigned* st;
};

__device__ __forceinline__ XcdBarrier xcd_barrier_post(unsigned* bar, volatile LAS unsigned* st) {
    XcdBarrier b; b.bar = bar; b.x = xb_xcc_id(); b.st = st;
    if (threadIdx.x == 0) (void)xb_add(&bar[XB_XCNT(b.x)], 1u);
    return b;
}
__device__ __forceinline__ void xcd_barrier_complete(unsigned* bar, unsigned x, unsigned& nloc, unsigned& nx) {
    const unsigned G = gridDim.x * gridDim.y * gridDim.z;
    unsigned sum, cnt, mine, sp = 0u;
    for (;;) {
        sum = 0u; cnt = 0u; mine = 0u;
#pragma unroll
        for (unsigned j = 0; j < 16; ++j) { const unsigned c = xb_ld(&bar[XB_XCNT(j)]); sum += c; cnt += (c > 0u) ? 1u : 0u; mine = (j == x) ? c : mine; }
        if (sum == G) break;
        __builtin_amdgcn_s_sleep(1);
        if ((++sp & 255u) == 0u) { if (xb_ld(&bar[XB_TMO])) break; if (sp > XB_SPIN_CAP) { atomicAdd(&bar[XB_TMO], 1u); break; } }
    }
    nloc = mine > 0u ? mine : 1u; nx = cnt > 0u ? cnt : 1u;
}

__device__ __forceinline__ void xcd_barrier(const XcdBarrier& b) {
    asm volatile("s_waitcnt vmcnt(0)" ::: "memory");
    __syncthreads();
    if (threadIdx.x == 0) {
        unsigned* bar = b.bar;
        __builtin_amdgcn_s_waitcnt(0);
        unsigned nloc = b.st[0], nx = b.st[1];
        if (nloc == 0u) { xcd_barrier_complete(bar, b.x, nloc, nx); b.st[0] = nloc; b.st[1] = nx; }
        const unsigned old = xb_add(&bar[XB_XSUB(b.x)], 1u);
        const unsigned gen = old / nloc;
        if (old + 1u == (gen + 1u) * nloc) {
            __builtin_amdgcn_fence(__ATOMIC_RELEASE, "agent");
            asm volatile("s_waitcnt vmcnt(0)" ::: "memory");
            const unsigned og = xb_add(&bar[XB_TOP], 1u);
            const unsigned tg = og / nx;
            if (og + 1u == (tg + 1u) * nx) xb_add(&bar[XB_TOPGEN], 1u);
            else XB_SPIN(xb_ld(&bar[XB_TOPGEN]) == tg, bar);
            __builtin_amdgcn_fence(__ATOMIC_ACQUIRE, "agent");
            xb_add(&bar[XB_XGEN(b.x)], 1u);
            asm volatile("s_waitcnt vmcnt(0)" ::: "memory");
        } else {
            XB_SPIN(xb_ld(&bar[XB_XGEN(b.x)]) == gen, bar);
            __builtin_amdgcn_fence(__ATOMIC_ACQUIRE, "agent");
            asm volatile("s_waitcnt vmcnt(0)" ::: "memory");
        }
    }
    __syncthreads();
}

constexpr int ATT_CK = 131072, ATT_XCH = 0, ATT_UNITW = 133120;
__device__ __forceinline__ unsigned offb(unsigned row, unsigned ch) { return 256u * row + 16u * (ch ^ (((row & 3u) << 2) | ((row >> 2) & 3u))); }
__device__ __forceinline__ unsigned tr_addr(unsigned lane, unsigned cb, unsigned ks, unsigned t) {
    const unsigned h = lane >> 5, blk = (lane >> 4) & 1, q = (lane & 15) >> 2, p = lane & 3;
    return offb(16 * ks + 8 * h + 4 * t + q, 4 * cb + 2 * blk + (p >> 1)) + 8 * (p & 1);
}
__device__ __forceinline__ s16x4 vtr(LAS const unsigned char* p) { typedef short v4i16_t __attribute__((ext_vector_type(4))); return __builtin_bit_cast(s16x4, __builtin_amdgcn_ds_read_tr16_b64_v4i16((LAS v4i16_t*)p)); }
#define MFMA32(a, b, c) __builtin_amdgcn_mfma_f32_32x32x16_bf16((a), (b), (c), 0, 0, 0)

template <bool FOX>
__device__ __forceinline__ void attn_unit(LAS unsigned char* lds, int b, int g, int j, const bf16_t* __restrict__ QALL, const bf16_t* __restrict__ K, const bf16_t* __restrict__ V,
                                          const bf16_t* __restrict__ G, const float* __restrict__ CF, const float* __restrict__ subln, float lam, float oml, float kinf, bf16_t* __restrict__ AO) {
    const int tid = opaque_tid(), lane = tid & 63, wid = rfl(tid >> 6), stream = wid >> 2, wq = wid & 3, l31 = lane & 31, hi = lane >> 5;
    constexpr int NCB = FOX ? 2 : 4;
    const size_t rowb = (size_t)b * LP;
    const int q0 = j * 128, qloc128 = 32 * wq + l31, qrow = q0 + qloc128;
    const int tq = 2 * j + (wq >> 1);
    const int NT = 2 * j + 1;
    bf16x8 qf[4];
    { const bf16_t* qp = QALL + (rowb + qrow) * DM + (FOX ? 512 : 0) + 128 * g + 64 * stream + 8 * hi;
#pragma unroll
      for (int s = 0; s < 4; ++s) qf[s] = *(const bf16x8*)(qp + 16 * s); }
    float cq2 = 0.f;
    if (FOX) cq2 = CF[(rowb + qrow) * 8 + 2 * g + stream] * LOG2E;
    const int r4 = lane >> 4, c16 = lane & 15;
    const int chA = c16 ^ ((r4 << 2) | ((2 * wid) & 3)), chB = c16 ^ ((r4 << 2) | ((2 * wid + 1) & 3));
    const bf16_t* kgA = K + (rowb + 8 * wid + r4) * 512 + 128 * g + 8 * chA;
    const bf16_t* kgB = K + (rowb + 8 * wid + 4 + r4) * 512 + 128 * g + 8 * chB;
    const bf16_t* vgA = V + (rowb + 8 * wid + r4) * 512 + 128 * g + 8 * chA;
    const bf16_t* vgB = V + (rowb + 8 * wid + 4 + r4) * 512 + 128 * g + 8 * chB;
    const float* cfg = CF + (rowb + lane) * 8 + 2 * g + (wid & 1);
#define ATT_DMA(t, sb) do { const size_t ro_ = (size_t)(64 * (t)) * 512; LAS unsigned char* d_ = lds + (sb) * 32768 + wid * 2048; \
        __builtin_amdgcn_global_load_lds((const unsigned*)(kgA + ro_), (LAS unsigned*)(d_), 16, 0, 0); \
        __builtin_amdgcn_global_load_lds((const unsigned*)(kgB + ro_), (LAS unsigned*)(d_ + 1024), 16, 0, 0); \
        __builtin_amdgcn_global_load_lds((const unsigned*)(vgA + ro_), (LAS unsigned*)(d_ + 16384), 16, 0, 0); \
        __builtin_amdgcn_global_load_lds((const unsigned*)(vgB + ro_), (LAS unsigned*)(d_ + 16384 + 1024), 16, 0, 0); \
        if (FOX) __builtin_amdgcn_global_load_lds((const unsigned*)(cfg + (size_t)(64 * (t)) * 8), (LAS unsigned*)(lds + ATT_CK + (sb) * 512 + (wid & 1) * 256), 4, 0, 0); } while (0)
#define ATT_WAIT_BAR(pending) do { if (pending) { if (FOX) asm volatile("s_waitcnt vmcnt(5) lgkmcnt(0)\n\ts_barrier" ::: "memory"); else asm volatile("s_waitcnt vmcnt(4) lgkmcnt(0)\n\ts_barrier" ::: "memory"); } \
        else asm volatile("s_waitcnt vmcnt(0) lgkmcnt(0)\n\ts_barrier" ::: "memory"); } while (0)
    const unsigned krow = (l31 & ~12u) | ((l31 & 4u) << 1) | ((l31 & 8u) >> 1);
    unsigned koff[4];
#pragma unroll
    for (int s = 0; s < 4; ++s) koff[s] = offb(krow, 8 * stream + 2 * s + hi);
    unsigned voff[NCB][2];
#pragma unroll
    for (int cb = 0; cb < NCB; ++cb)
#pragma unroll
        for (int t = 0; t < 2; ++t) voff[cb][t] = 16384u + tr_addr(lane, FOX ? 2 * stream + cb : cb, 0, t);
    f32x16 o[NCB];
#pragma unroll
    for (int cb = 0; cb < NCB; ++cb)
#pragma unroll
        for (int r = 0; r < 16; ++r) o[cb][r] = 0.f;
    float lsum = 0.f;
    const int qloc64 = 32 * (wq & 1) + l31;

    constexpr float THR = 96.0f, SKIP_T = 40.0f;
    float ub = 0.f, qb;
    {
        float q1 = 0.f;
#pragma unroll
        for (int s = 0; s < 4; ++s)
#pragma unroll
            for (int e = 0; e < 8; ++e) q1 += fabsf(bf2f((unsigned short)qf[s][e]));
        q1 = swap_add(q1);
        qb = q1 * kinf * 1.01f;
        if (FOX) ub = qb + cq2 + SKIP_T;
    }
    bool needmax = true;
    volatile LAS int* flags = (volatile LAS int*)(lds + ATT_UNITW + 64);
    int t = FOX ? NT : 1;
    ATT_DMA(t, 0);
    { const int t1_ = FOX ? t - 1 : t + 1; const bool h1_ = FOX ? (t1_ >= 1) : (t1_ <= NT); if (h1_) ATT_DMA(t1_, 1); ATT_WAIT_BAR(h1_); }
    bool wmore = (tq >= 1), first = true;
    float mref = 0.f;
    f32x16 negm;
#pragma unroll
    for (int r = 0; r < 16; ++r) negm[r] = 0.f;
    bf16x8 pf[4];
#pragma unroll
    for (int s = 0; s < 4; ++s) pf[s] = (bf16x8){0, 0, 0, 0, 0, 0, 0, 0};
#define ATT_SB() __builtin_amdgcn_sched_barrier(0)
#define ATT_VRD(arr, ks) do { _Pragma("unroll") for (int cb = 0; cb < NCB; ++cb) { arr[cb][0] = vtr(vbp_ + voff[cb][0] + 4096 * (ks)); arr[cb][1] = vtr(vbp_ + voff[cb][1] + 4096 * (ks)); } } while (0)
#define ATT_MM(arr, ks) do { _Pragma("unroll") for (int cb = 0; cb < NCB; ++cb) { const bf16x8 vf = {arr[cb][0][0], arr[cb][0][1], arr[cb][0][2], arr[cb][0][3], arr[cb][1][0], arr[cb][1][1], arr[cb][1][2], arr[cb][1][3]}; o[cb] = MFMA32(vf, pf[ks], o[cb]); } } while (0)
#define ATT_EXPCH(S, B, DST) do { _Pragma("unroll") for (int r = (B); r < (B) + 8; r += 2) { S[r] = __builtin_amdgcn_exp2f(S[r]); S[r + 1] = __builtin_amdgcn_exp2f(S[r + 1]); ps2.x = fadd_s(ps2.x, S[r]); ps2.y = fadd_s(ps2.y, S[r + 1]); } \
        u32x4 w_; w_.x = pk2(S[B], S[(B) + 1]); w_.y = pk2(S[(B) + 2], S[(B) + 3]); w_.z = pk2(S[(B) + 4], S[(B) + 5]); w_.w = pk2(S[(B) + 6], S[(B) + 7]); DST = __builtin_bit_cast(bf16x8, w_); asm volatile("" : "+v"(DST), "+v"(ps2)); } while (0)
    int pbuf = 0, buf = 0;
    for (;;) {
        const int tn = FOX ? t - 1 : t + 1, tn2 = FOX ? t - 2 : t + 2;
        const bool have_next = FOX ? (tn >= 1) : (tn <= NT), have_next2 = FOX ? (tn2 >= 1) : (tn2 <= NT);
        const int nbuf = (buf + 1) & 3;
        const bool act = (t <= tq) && wmore;
        LAS const unsigned char* vbp_ = lds + pbuf * 32768;
        LAS const unsigned char* kb = lds + buf * 32768;
        s16x4 va[NCB][2];
        f32x16 s0, s1;
        float ckfirst = 0.f, alpha_o = 1.f; bool resc = false;
        if (act) {
            bf16x8 kf[8];
#pragma unroll
            for (int s = 0; s < 4; ++s) { kf[2 * s] = *(LAS const bf16x8*)(kb + koff[s]); kf[2 * s + 1] = *(LAS const bf16x8*)(kb + koff[s] + 8192); }
            if (have_next2) ATT_DMA(tn2, (buf + 2) & 3);
            if (FOX) {
                LAS const float* ck = (LAS const float*)(lds + ATT_CK + buf * 512) + 64 * stream;
                ckfirst = ck[0] * LOG2E;
                ck += 8 * hi;
                const float cqm = cq2 - mref;
#pragma unroll
                for (int rr = 0; rr < 2; ++rr) {
                    const f32x4 a0 = *(LAS const f32x4*)(ck + 16 * rr), a1 = *(LAS const f32x4*)(ck + 16 * rr + 4), b0 = *(LAS const f32x4*)(ck + 32 + 16 * rr), b1 = *(LAS const f32x4*)(ck + 32 + 16 * rr + 4);
#pragma unroll
                    for (int e = 0; e < 4; ++e) { s0[8 * rr + e] = cqm - LOG2E * a0[e]; s0[8 * rr + 4 + e] = cqm - LOG2E * a1[e]; s1[8 * rr + e] = cqm - LOG2E * b0[e]; s1[8 * rr + 4 + e] = cqm - LOG2E * b1[e]; }
                }
                ATT_SB();
                s0 = MFMA32(kf[0], qf[0], s0); s1 = MFMA32(kf[1], qf[0], s1);
            } else {
                ATT_SB();
                s0 = MFMA32(kf[0], qf[0], negm); s1 = MFMA32(kf[1], qf[0], negm);
            }
#pragma unroll
            for (int s = 1; s < 4; ++s) { s0 = MFMA32(kf[2 * s], qf[s], s0); s1 = MFMA32(kf[2 * s + 1], qf[s], s1); }
        } else {
            if (have_next2) ATT_DMA(tn2, (buf + 2) & 3);
#pragma unroll
            for (int r = 0; r < 16; ++r) { s0[r] = -INFINITY; s1[r] = -INFINITY; }
        }
        ATT_VRD(va, 0);
        ATT_SB();
        if (t == 1) {
#pragma unroll
            for (int r = 0; r < 16; ++r) s0[r] = -INFINITY;
#pragma unroll
            for (int r = 0; r < 8; ++r) s1[r] = -INFINITY;
        }
        if (FOX && t == tq) {
#pragma unroll
            for (int r = 0; r < 16; ++r) { const int kl = 16 * (r >> 3) + 8 * hi + (r & 7); if (kl > qloc64) s0[r] = -INFINITY; if (kl + 32 > qloc64) s1[r] = -INFINITY; }
        }
        float mx = 0.f; bool upd = false;
        if (needmax) {
            float mxa = max3f(s0[0], s0[1], s1[0]), mxb = max3f(s0[2], s0[3], s1[1]);
            mxa = max3f(mxa, s1[2], s1[3]);
#pragma unroll
            for (int r = 4; r < 16; r += 4) { mxa = max3f(mxa, s0[r], s0[r + 1]); mxb = max3f(mxb, s0[r + 2], s0[r + 3]); mxa = max3f(mxa, s1[r], s1[r + 1]); mxb = max3f(mxb, s1[r + 2], s1[r + 3]); }
            mx = swap_max(fmaxf(mxa, mxb));
            upd = (first && act) || __any(mx > THR);
        }
        if (upd) {
            const float dl = first ? mx : fmaxf(mx, 0.f);
            alpha_o = __builtin_amdgcn_exp2f(-dl); resc = !first;
            mref += dl;
#pragma unroll
            for (int r = 0; r < 16; ++r) { s0[r] -= dl; s1[r] -= dl; }
            lsum *= alpha_o;
            if (!FOX) {
#pragma unroll
                for (int r = 0; r < 16; ++r) negm[r] = -mref;
            }
            first = false;
            needmax = __any(qb - mref > THR) != 0;
        }
        ATT_SB();
        f32x2v ps2 = {0.f, 0.f};
        ATT_MM(va, 0); ATT_VRD(va, 1); ATT_EXPCH(s0, 0, pf[0]); ATT_SB();
        ATT_MM(va, 1); ATT_VRD(va, 2); ATT_EXPCH(s0, 8, pf[1]); ATT_SB();
        ATT_MM(va, 2); ATT_VRD(va, 3); ATT_EXPCH(s1, 0, pf[2]); ATT_SB();
        ATT_MM(va, 3); ATT_EXPCH(s1, 8, pf[3]); ATT_SB();
        lsum += ps2.x + ps2.y;
        if (resc) {
#pragma unroll
            for (int cb = 0; cb < NCB; ++cb)
#pragma unroll
                for (int r = 0; r < 16; ++r) o[cb][r] *= alpha_o;
        }
        pbuf = buf;
        if (FOX && act) wmore = __any(ub - mref > ckfirst) != 0;
        bool cont = have_next;
        if (FOX) { if (lane == 0) flags[buf * 8 + wid] = wmore ? 1 : 0; }
        ATT_WAIT_BAR(have_next2);
        if (FOX && cont) { int any_ = 0;
#pragma unroll
            for (int w8 = 0; w8 < 8; ++w8) any_ |= flags[buf * 8 + w8];
            cont = rfl(any_) != 0; }
        if (!cont) break;
        t = tn; buf = nbuf;
    }
    u32x2 gpre[NCB][4];
#pragma unroll
    for (int cb = 0; cb < NCB; ++cb)
#pragma unroll
        for (int gq = 0; gq < 4; ++gq) gpre[cb][gq] = (u32x2){0u, 0u};
    if (FOX || stream == 0) {
        const bf16_t* gp_ = G + (rowb + qrow) * 512 + 128 * g + (FOX ? 64 * stream : 0) + 4 * hi;
#pragma unroll
        for (int cb = 0; cb < NCB; ++cb)
#pragma unroll
            for (int gq = 0; gq < 4; ++gq) gpre[cb][gq] = *(const u32x2*)(gp_ + 32 * cb + 8 * gq);
    }
    { LAS const unsigned char* vbp_ = lds + pbuf * 32768; s16x4 va[NCB][2];
        ATT_VRD(va, 0); ATT_SB();
        ATT_MM(va, 0); ATT_VRD(va, 1); ATT_SB();
        ATT_MM(va, 1); ATT_VRD(va, 2); ATT_SB();
        ATT_MM(va, 2); ATT_VRD(va, 3); ATT_SB();
        ATT_MM(va, 3); ATT_SB(); }
#undef ATT_SB
#undef ATT_VRD
#undef ATT_MM
#undef ATT_EXPCH
    if (!FOX) __syncthreads();
    lsum = swap_add(lsum);
    const float invl = 1.0f / lsum;
    int qrow_e = qrow; asm volatile("" : "+v"(qrow_e));
    const int grow_i = g_row(b, qrow_e);
    const size_t grow = (size_t)(grow_i < 0 ? MROWS - 1 : grow_i);
    if (FOX) {
        const int colb = 128 * g + 64 * stream;
#pragma unroll
        for (int cb = 0; cb < 2; ++cb)
#pragma unroll
            for (int gq = 0; gq < 4; ++gq) {
                const int d0 = 32 * cb + 8 * gq + 4 * hi;
                const u32x2 gt = gpre[cb][gq];
                float v0 = o[cb][4 * gq] * invl * bf2f((unsigned short)(gt.x & 0xffff)), v1 = o[cb][4 * gq + 1] * invl * bf2f((unsigned short)(gt.x >> 16));
                float v2 = o[cb][4 * gq + 2] * invl * bf2f((unsigned short)(gt.y & 0xffff)), v3 = o[cb][4 * gq + 3] * invl * bf2f((unsigned short)(gt.y >> 16));
                u32x2 w; w.x = pk2(v0, v1); w.y = pk2(v2, v3);
                *(u32x2*)(AO + grow * DM + 512 + colb + d0) = w;
            }
    } else {
        LAS float* xch = (LAS float*)(lds + ATT_XCH) + wq * 4096 + lane;
        if (stream == 1) {
#pragma unroll
            for (int cb = 0; cb < NCB; ++cb)
#pragma unroll
                for (int r = 0; r < 16; ++r) xch[(cb * 16 + r) * 64] = o[cb][r] * invl;
        }
        __syncthreads();
        if (stream == 0) {
            float ss = 0.f;
#pragma unroll
            for (int cb = 0; cb < NCB; ++cb)
#pragma unroll
                for (int r = 0; r < 16; ++r) { const float v = o[cb][r] * invl - lam * xch[(cb * 16 + r) * 64]; o[cb][r] = v; ss += v * v; }
            ss = swap_add(ss);
            const float rs = oml / sqrtf(ss * (1.0f / 128.0f) + 1e-5f);
#pragma unroll
            for (int cb = 0; cb < NCB; ++cb)
#pragma unroll
                for (int gq = 0; gq < 4; ++gq) {
                    const int d0 = 32 * cb + 8 * gq + 4 * hi;
                    const f32x4 sg = *(const f32x4*)(subln + d0);
                    const u32x2 gt = gpre[cb][gq];
                    float v0 = o[cb][4 * gq] * rs * sg[0] * bf2f((unsigned short)(gt.x & 0xffff)), v1 = o[cb][4 * gq + 1] * rs * sg[1] * bf2f((unsigned short)(gt.x >> 16));
                    float v2 = o[cb][4 * gq + 2] * rs * sg[2] * bf2f((unsigned short)(gt.y & 0xffff)), v3 = o[cb][4 * gq + 3] * rs * sg[3] * bf2f((unsigned short)(gt.y >> 16));
                    u32x2 w; w.x = pk2(v0, v1); w.y = pk2(v2, v3);
                    *(u32x2*)(AO + grow * DM + 128 * g + d0) = w;
                }
        }
    }
}

__device__ __forceinline__ void attn_phase(LAS unsigned char* lds, const Args& a, int layer, unsigned* counters) {
    const int tid = opaque_tid(), lane = tid & 63;
    const bf16_t* QALL = (const bf16_t*)(a.ws + WS_QALL); bf16_t* AO = (bf16_t*)(a.ws + WS_HN);
    float kinf8[8], kinfd4[4];
#pragma unroll
    for (int i = 0; i < 4; ++i) kinfd4[i] = __uint_as_float(__hip_atomic_load((unsigned*)(a.ws + WS_CTL) + CW_KINFD + layer * 4 + i, __ATOMIC_RELAXED, __HIP_MEMORY_SCOPE_AGENT));
#pragma unroll
    for (int i = 0; i < 8; ++i) kinf8[i] = __uint_as_float(__hip_atomic_load((unsigned*)(a.ws + WS_CTL) + CW_KINF + layer * 8 + i, __ATOMIC_RELAXED, __HIP_MEMORY_SCOPE_AGENT));
    const bf16_t* KD = (const bf16_t*)(a.ws + WS_KD); const bf16_t* VD = (const bf16_t*)(a.ws + WS_VD); const bf16_t* GD = (const bf16_t*)(a.ws + WS_GD);
    const bf16_t* KF = (const bf16_t*)(a.ws + WS_KF); const bf16_t* VF = (const bf16_t*)(a.ws + WS_VF); const bf16_t* GF = (const bf16_t*)(a.ws + WS_GF);
    const float* CF = (const float*)(a.ws + WS_CF);
    const float d1 = wave_sum(a.lq1[layer * 64 + lane] * a.lk1[layer * 64 + lane]), d2 = wave_sum(a.lq2[layer * 64 + lane] * a.lk2[layer * 64 + lane]);
    const float lam_init = a.lam_init[layer];
    const float lam = expf(d1) - expf(d2) + lam_init, oml = 1.0f - lam_init;
    volatile LAS int* uw = (volatile LAS int*)(lds + ATT_UNITW);
    const int myx = (int)(xb_xcc_id() & 7u);
    int qx = myx, tried = 0, ip = 0;
    if (tid == 0) ip = (int)atomicAdd(counters + 64 * qx, 1u);
    for (;;) {
        __syncthreads();
        if (tid == 0) {
            int got = -1, q = qx, tr = tried, i = ip;
            for (;;) { if (i < 260) { got = q * 260 + i; break; } q = (q + 1) & 7; ++tr; if (tr >= 8) break; i = (int)atomicAdd(counters + 64 * q, 1u); }
            uw[0] = got; uw[1] = q; uw[2] = tr;
        }
        __syncthreads();
        const int u = rfl(uw[0]); qx = rfl(uw[1]); tried = rfl(uw[2]);
        if (u < 0) break;
        if (tid == 0) ip = (int)atomicAdd(counters + 64 * qx, 1u);
        const int q = u / 260, i = u % 260;
        if (i < 130) { const int j = NBLK - 1 - (i >> 1), bh = q + 8 * (i & 1); attn_unit<false>(lds, bh >> 2, bh & 3, j, QALL, KD, VD, GD, CF, a.subln + layer * 128, lam, oml, 1.42f * kinfd4[bh & 3], AO); }
        else { const int v = i - 130; const int j = NBLK - 1 - (v >> 1), bh = q + 8 * (v & 1); const int g = bh & 3; const float kinf = fmaxf(kinf8[2 * g], kinf8[2 * g + 1]);
               attn_unit<true>(lds, bh >> 2, g, j, QALL, KF, VF, GF, CF, nullptr, 0.f, 0.f, kinf, AO); }
    }
}

__global__ void __launch_bounds__(512, 2) hymba_fwd(Args a) {
    extern __shared__ __attribute__((aligned(16))) unsigned char lds_raw[];
    LAS unsigned char* lds = (LAS unsigned char*)lds_raw;
    cg::grid_group grid = cg::this_grid();
    unsigned* ctl = (unsigned*)(a.ws + WS_CTL);
    const bf16_t* HN = (const bf16_t*)(a.ws + WS_HN);
    bf16_t* QALL = (bf16_t*)(a.ws + WS_QALL);
    if (threadIdx.x < 2) ((volatile LAS unsigned*)(lds + ATT_UNITW + 256))[threadIdx.x] = 0u;
    __syncthreads();
    const XcdBarrier bar = xcd_barrier_post(ctl + CW_BAR, (volatile LAS unsigned*)(lds + ATT_UNITW + 256));
    prologue_phase(lds, a);
    __syncthreads();
    for (int layer = 0; layer < DEPTH; ++layer) {
        norm_phase(lds, a, layer);
        if (layer == 0) grid.sync(); else xcd_barrier(bar);
        cumfix_phase(lds, a);
        {
            pg8::Gemm g{(const bf16_t*)(a.ws + WS_H), (const bf16_t*)(a.ws + WS_WIN) + (size_t)layer * NPROJ * DM, MROWS, NPROJ, DM};
            pg8::StaticOrder S; S.init(GTOK, NPROJ, (int)gridDim.x, (int)blockIdx.x);
            EpiInProj E{QALL, (bf16_t*)(a.ws + WS_KD), (bf16_t*)(a.ws + WS_VD), (bf16_t*)(a.ws + WS_GD), (bf16_t*)(a.ws + WS_KF), (bf16_t*)(a.ws + WS_VF), (bf16_t*)(a.ws + WS_GF),
                        (const float*)(a.ws + WS_ROPE), (const float*)(a.ws + WS_ROPE) + LP * 8, ctl + CW_KINF + layer * 8, ctl + CW_KINFD + layer * 4, (const float*)(a.ws + WS_RSTD)};
            meta_inproj(lds, (const bf16_t*)(a.ws + WS_H), (const bf16_t*)(a.ws + WS_WIN) + (size_t)layer * NPROJ * DM, E);
            pg8::gemm_phase<EpiInProj, pg8::StaticOrder, true, true>(lds, g, S, E);
        }
        xcd_barrier(bar);
        attn_phase(lds, a, layer, ctl + 64 * (1 + layer * 8));
        xcd_barrier(bar);
        {
            pg8::Gemm g{HN, (const bf16_t*)(a.ws + WS_WOUT) + (size_t)layer * DM * DM, MROWS, DM, DM};
            pg8::StaticOrder S; S.init(GTOK, DM, (int)gridDim.x, (int)blockIdx.x);
            EpiResid E{(bf16_t*)(a.ws + WS_Y)};
            meta_outproj(lds, HN, (const bf16_t*)(a.ws + WS_WOUT) + (size_t)layer * DM * DM, (bf16_t*)(a.ws + WS_Y));
            pg8::gemm_phase<EpiResid, pg8::StaticOrder, true, true>(lds, g, S, E);
        }
        xcd_barrier(bar);
    }
    final_phase(a);
}

extern "C" void kernel_launch(void* const* d_in, const int* in_sizes, int n_in, void* d_out, int out_size, void* d_ws, size_t ws_size, hipStream_t stream) {
    static int grid = 0;
    if (grid == 0) {
        if (n_in != 12 || ws_size < WS_END) { fprintf(stderr, "kernel_launch: bad inputs (n_in %d, ws %zu < %zu)\n", n_in, ws_size, (size_t)WS_END); grid = -1; return; }
        int dev = 0, cus = 0, per_cu = 0;
        hipGetDevice(&dev); hipDeviceGetAttribute(&cus, hipDeviceAttributeMultiprocessorCount, dev);
        if (hipFuncSetAttribute((const void*)hymba_fwd, hipFuncAttributeMaxDynamicSharedMemorySize, LDS_BYTES) != hipSuccess) { fprintf(stderr, "hipFuncSetAttribute failed\n"); grid = -1; return; }
        if (hipOccupancyMaxActiveBlocksPerMultiprocessor(&per_cu, (const void*)hymba_fwd, 512, LDS_BYTES) != hipSuccess || per_cu < 1) { fprintf(stderr, "occupancy query: %d\n", per_cu); per_cu = 1; }
        (void)hipGetLastError();
        grid = cus * per_cu;
    }
    if (grid < 0) return;
    (void)hipMemsetAsync((char*)d_ws + WS_CTL, 0, CTL_BYTES, stream);
    Args a{};
    a.x = (const float*)d_in[0]; a.meta = (const float*)d_in[1]; a.norm_gain = (const float*)d_in[2]; a.w_in = (const float*)d_in[3]; a.forget_bias = (const float*)d_in[4];
    a.lq1 = (const float*)d_in[5]; a.lk1 = (const float*)d_in[6]; a.lq2 = (const float*)d_in[7]; a.lk2 = (const float*)d_in[8]; a.subln = (const float*)d_in[9];
    a.w_out = (const float*)d_in[10]; a.final_gain = (const float*)d_in[11];
    a.out = (float*)d_out; a.ws = (unsigned char*)d_ws;
    for (int l = 0; l < 4; ++l) a.lam_init[l] = (float)(0.8 - 0.6 * exp(-0.3 * (double)l));
    for (int i = 0; i < 8; ++i) a.inv_freq[i] = (float)(1.0 / pow(500000.0, (double)(2 * i) / 16.0));
    void* args[] = {&a};
    hipError_t e = hipLaunchCooperativeKernel((const void*)hymba_fwd, dim3(grid), dim3(512), args, LDS_BYTES, stream);
    if (e != hipSuccess) fprintf(stderr, "cooperative launch failed: %s (grid %d)\n", hipGetErrorString(e), grid);
}
```

```cpp
#include <hip/hip_runtime.h>
#include <hip/hip_cooperative_groups.h>
#include <cstdio>
#include <cstdint>
#include <cmath>
namespace cg = cooperative_groups;
namespace pg8 {
#define PG8_LAS __attribute__((address_space(3)))
typedef unsigned short bf16_t;
typedef short bf16x8 __attribute__((ext_vector_type(8)));
typedef float f32x4 __attribute__((ext_vector_type(4)));
typedef unsigned u32x4 __attribute__((ext_vector_type(4)));
constexpr int BM = 256, BK = 64, HALF = 128, HTB = HALF * BK * 2  , STAGE_BYTES = 8 * HTB, NXCD = 8, WGM = 8;

__host__ __device__ __forceinline__ int lds_byte(int r, int c) { const int st = (r >> 4) * 2 + (c >> 5), rr = r & 15, cc = c & 31, ob = rr * 64 + cc * 2; return st * 1024 + (ob ^ (((ob >> 9) & 1) << 5)); }
__host__ __device__ __forceinline__ void stage_rc(int b, int& R, int& C) { const int st = b / 1024, sb = b % 1024, swz = sb ^ (((sb >> 9) & 1) << 5); R = (st >> 1) * 16 + swz / 64; C = (st & 1) * 32 + (swz % 64) / 2; }
__host__ __device__ __forceinline__ int perm32(int rho) { const int n = rho >> 4, i = rho & 15; return 8 * (i >> 2) + 4 * n + (i & 3); }

struct Unit { int pm, pn; };
struct Gemm { const bf16_t* A; const bf16_t* Bt; int M, N, K; };

struct StaticOrder {
    int nM, nN, nwg, G, c;
    __host__ __device__ void init(int M, int N, int G_, int c_) { nM = M / BM; nN = N / BM; nwg = nM * nN; G = G_; c = c_; }
    __host__ __device__ bool next(int i, Unit& u) const {
        const long L = (long)i * G + c; if (L >= nwg) return false;
        int wgid = (int)L; { const int q = nwg / NXCD, r = nwg % NXCD, xcd = wgid % NXCD, off = wgid / NXCD; wgid = (xcd < r ? xcd * (q + 1) : r * (q + 1) + (xcd - r) * q) + off; }
        const int nig = WGM * nN, gid = wgid / nig, fm = gid * WGM, gsz = (nM - fm) < WGM ? (nM - fm) : WGM;
        u.pm = fm + ((wgid % nig) % gsz); u.pn = (wgid % nig) / gsz; return true;
    }
    __device__ __forceinline__ void a_ready(const Unit&) const {}
    __device__ __forceinline__ void done(const Unit&) const {}
};

__device__ __forceinline__ unsigned cvt_pk_bf16(float lo, float hi) { unsigned r; asm volatile("v_cvt_pk_bf16_f32 %0, %1, %2" : "=v"(r) : "v"(lo), "v"(hi)); return r; }
typedef float f32x2 __attribute__((ext_vector_type(2)));
template <class Epi, class Sched, bool ALIGN_EPI = false, bool SP2 = false>
__device__ __forceinline__ void gemm_phase(PG8_LAS unsigned char* lds, const Gemm g, const Sched& S, const Epi& E) {
    int tid_ = threadIdx.x; asm volatile("" : "+v"(tid_));
    const int tid = tid_, wid = __builtin_amdgcn_readfirstlane(tid >> 6), lane = tid & 63, wr = wid >> 2, wc = wid & 3, fr = lane & 15, fq = lane >> 4;
    const int K = g.K, nt = K / BK;
    unsigned voffA[2], voffB[2];
#pragma unroll
    for (int i = 0; i < 2; ++i) { int R, C; stage_rc(tid * 16 + i * 8192, R, C); const int Rb = Epi::PERM ? ((R & ~31) + perm32(R & 31)) : R;
        voffA[i] = (unsigned)(R * K + C) * 2u; voffB[i] = (unsigned)(Rb * K + C) * 2u; }
    const size_t kstep = (size_t)(BK * 2);
    const size_t hstep = (size_t)HALF * K * 2;
    const size_t tstep = 2 * hstep;
    const unsigned ldsw = (unsigned)wid * 1024u;
    const int aoff = lds_byte(wr * 64 + fr, fq * 8), boff = lds_byte(wc * 32 + fr, fq * 8);
#define PG8_SA(b, h) (((b) * 2 + (h)) * HTB)
#define PG8_SB(b, h) ((4 + (b) * 2 + (h)) * HTB)
#define PG8_STAGE(bufoff, gbase, voff) do { _Pragma("unroll") for (int _i = 0; _i < 2; ++_i) \
        __builtin_amdgcn_global_load_lds((const unsigned*)((const char*)(gbase) + (voff)[_i]), (PG8_LAS unsigned*)(lds + (bufoff) + ldsw + _i * 8192), 16, 0, 0); } while (0)
#define PG8_LDA(dst, b, h) do { _Pragma("unroll") for (int m = 0; m < 4; ++m) _Pragma("unroll") for (int k = 0; k < 2; ++k) dst[m][k] = *(const PG8_LAS bf16x8*)(lds + PG8_SA(b, h) + aoff + m * 2048 + k * 1024); } while (0)
#define PG8_LDB(dst, b, h) do { _Pragma("unroll") for (int n = 0; n < 2; ++n) _Pragma("unroll") for (int k = 0; k < 2; ++k) dst[n][k] = *(const PG8_LAS bf16x8*)(lds + PG8_SB(b, h) + boff + n * 2048 + k * 1024); } while (0)
#define PG8_MMA(ai, bj, At, Bt) do { __builtin_amdgcn_s_setprio(1); _Pragma("unroll") for (int m = 0; m < 4; ++m) _Pragma("unroll") for (int n = 0; n < 2; ++n) _Pragma("unroll") for (int k = 0; k < 2; ++k) \
        acc[ai][bj][m][n] = __builtin_amdgcn_mfma_f32_16x16x32_bf16(Bt[n][k], At[m][k], acc[ai][bj][m][n], 0, 0, 0); __builtin_amdgcn_s_setprio(0); } while (0)
#define PG8_WAIT_V(n) asm volatile("s_waitcnt vmcnt(" #n ")" ::: "memory")
#define PG8_WAIT_L(n) asm volatile("s_waitcnt lgkmcnt(" #n ")" ::: "memory")
#define PG8_BAR __builtin_amdgcn_s_barrier()
#define PG8_SCHED __builtin_amdgcn_sched_barrier(0)
    Unit cur, nxt; int ui = 0;
    if (!S.next(0, cur)) return;
    f32x4 acc[2][2][4][2];
#pragma unroll
    for (int a = 0; a < 2; ++a)
#pragma unroll
        for (int b = 0; b < 2; ++b)
#pragma unroll
            for (int m = 0; m < 4; ++m)
#pragma unroll
                for (int n = 0; n < 2; ++n) acc[a][b][m][n] = (f32x4){0.f, 0.f, 0.f, 0.f};
    bf16x8 At[4][2], B0[2][2], B1[2][2];
    const char* cA = (const char*)g.A + (size_t)cur.pm * tstep; const char* cB = (const char*)g.Bt + (size_t)cur.pn * tstep;
    S.a_ready(cur);
    if constexpr (SP2) {
        PG8_STAGE(PG8_SB(0, 0), cB, voffB); PG8_STAGE(PG8_SB(0, 1), cB + hstep, voffB); PG8_STAGE(PG8_SA(0, 0), cA, voffA); PG8_STAGE(PG8_SA(0, 1), cA + hstep, voffA);
        if (wr == 1) PG8_BAR;
        PG8_WAIT_V(2); PG8_BAR;
        PG8_STAGE(PG8_SB(1, 0), cB + kstep, voffB); PG8_STAGE(PG8_SA(1, 0), cA + kstep, voffA); PG8_STAGE(PG8_SB(1, 1), cB + hstep + kstep, voffB);
        PG8_WAIT_V(6); PG8_BAR;
    } else {
        PG8_STAGE(PG8_SB(0, 0), cB, voffB); PG8_STAGE(PG8_SA(0, 0), cA, voffA); PG8_STAGE(PG8_SB(0, 1), cB + hstep, voffB); PG8_STAGE(PG8_SA(0, 1), cA + hstep, voffA);
        if (wr == 1) PG8_BAR;
        PG8_WAIT_V(4); PG8_BAR;
        PG8_STAGE(PG8_SB(1, 0), cB + kstep, voffB); PG8_STAGE(PG8_SA(1, 0), cA + kstep, voffA); PG8_STAGE(PG8_SB(1, 1), cB + hstep + kstep, voffB);
        PG8_WAIT_V(6); PG8_BAR;
    }
    for (;;) {
        const bool has_next = S.next(ui + 1, nxt);
        const char* nA = has_next ? (const char*)g.A + (size_t)nxt.pm * tstep : cA; const char* nB = has_next ? (const char*)g.Bt + (size_t)nxt.pn * tstep : cB;
        for (int t = 0; t < nt; t += 2) {
            const bool last = (t == nt - 2);
            const char* a1 = cA + (size_t)(t + 1) * kstep;
            const char* a2 = last ? nA : cA + (size_t)(t + 2) * kstep; const char* b2 = last ? nB : cB + (size_t)(t + 2) * kstep;
            const char* a3 = a2 + kstep; const char* b3 = b2 + kstep;
            if (last && has_next) S.a_ready(nxt);
            if constexpr (SP2) {
            PG8_LDB(B0, 0, 0); PG8_LDB(B1, 0, 1); PG8_SCHED; PG8_LDA(At, 0, 0); PG8_STAGE(PG8_SA(1, 1), a1 + hstep, voffA);
            PG8_WAIT_V(8); PG8_WAIT_L(0); PG8_BAR; PG8_MMA(0, 0, At, B0); PG8_MMA(0, 1, At, B1); PG8_BAR; PG8_SCHED;
            PG8_LDA(At, 0, 1); PG8_STAGE(PG8_SB(0, 0), b2, voffB); PG8_STAGE(PG8_SB(0, 1), b2 + hstep, voffB); PG8_STAGE(PG8_SA(0, 0), a2, voffA);
            PG8_WAIT_V(8); PG8_WAIT_L(0); PG8_BAR; PG8_MMA(1, 0, At, B0); PG8_MMA(1, 1, At, B1); PG8_BAR; PG8_SCHED;
            PG8_LDB(B0, 1, 0); PG8_LDB(B1, 1, 1); PG8_SCHED; PG8_LDA(At, 1, 0); PG8_STAGE(PG8_SA(0, 1), a2 + hstep, voffA);
            PG8_WAIT_V(8); PG8_WAIT_L(0); PG8_BAR; PG8_MMA(0, 0, At, B0); PG8_MMA(0, 1, At, B1); PG8_BAR; PG8_SCHED;
            PG8_LDA(At, 1, 1); PG8_STAGE(PG8_SB(1, 0), b3, voffB); PG8_STAGE(PG8_SB(1, 1), b3 + hstep, voffB); PG8_STAGE(PG8_SA(1, 0), a3, voffA);
            PG8_WAIT_V(8); PG8_WAIT_L(0); PG8_BAR; PG8_MMA(1, 0, At, B0); PG8_MMA(1, 1, At, B1); PG8_BAR; PG8_SCHED;
            } else {
            PG8_LDB(B0, 0, 0); PG8_SCHED; PG8_LDA(At, 0, 0); PG8_STAGE(PG8_SA(1, 1), a1 + hstep, voffA);
            PG8_WAIT_L(8); PG8_BAR; PG8_WAIT_L(0); PG8_MMA(0, 0, At, B0); PG8_BAR; PG8_SCHED;
            PG8_LDB(B1, 0, 1); PG8_STAGE(PG8_SB(0, 0), b2, voffB);
            PG8_BAR; PG8_WAIT_L(0); PG8_MMA(0, 1, At, B1); PG8_BAR;
            PG8_LDA(At, 0, 1); PG8_STAGE(PG8_SA(0, 0), a2, voffA);
            PG8_BAR; PG8_WAIT_L(0); PG8_MMA(1, 0, At, B0); PG8_BAR; PG8_SCHED;
            PG8_STAGE(PG8_SB(0, 1), b2 + hstep, voffB);
            PG8_WAIT_V(6); PG8_BAR; PG8_MMA(1, 1, At, B1); PG8_BAR;
            PG8_LDB(B0, 1, 0); PG8_SCHED; PG8_LDA(At, 1, 0); PG8_STAGE(PG8_SA(0, 1), a2 + hstep, voffA);
            PG8_WAIT_L(8); PG8_BAR; PG8_WAIT_L(0); PG8_MMA(0, 0, At, B0); PG8_BAR; PG8_SCHED;
            PG8_LDB(B1, 1, 1); PG8_STAGE(PG8_SB(1, 0), b3, voffB);
            PG8_BAR; PG8_WAIT_L(0); PG8_MMA(0, 1, At, B1); PG8_BAR;
            PG8_LDA(At, 1, 1); PG8_STAGE(PG8_SA(1, 0), a3, voffA);
            PG8_BAR; PG8_WAIT_L(0); PG8_MMA(1, 0, At, B0); PG8_BAR; PG8_SCHED;
            PG8_STAGE(PG8_SB(1, 1), b3 + hstep, voffB);
            PG8_WAIT_V(6); PG8_BAR; PG8_MMA(1, 1, At, B1); PG8_BAR;
            }
        }
        if constexpr (ALIGN_EPI) { if (wr == 0) PG8_BAR; }
        if constexpr (!Epi::AFTER_DRAIN) { E(acc, cur, wr, wc, fr, fq); S.done(cur); }
        if (!has_next) break;
#pragma unroll
        for (int a = 0; a < 2; ++a)
#pragma unroll
            for (int b = 0; b < 2; ++b)
#pragma unroll
                for (int m = 0; m < 4; ++m)
#pragma unroll
                    for (int n = 0; n < 2; ++n) acc[a][b][m][n] = (f32x4){0.f, 0.f, 0.f, 0.f};
        cur = nxt; cA = nA; cB = nB; ++ui;
        if constexpr (ALIGN_EPI) { if (wr == 1) PG8_BAR; }
    }
    PG8_WAIT_V(0);
    if constexpr (!ALIGN_EPI) { if (wr == 0) PG8_BAR; }
    PG8_BAR;
    if constexpr (Epi::AFTER_DRAIN) { E.fused(acc, cur, wr, wc, fr, fq, lds, wid, lane); S.done(cur); }
#undef PG8_SA
#undef PG8_SB
#undef PG8_STAGE
#undef PG8_LDA
#undef PG8_LDB
#undef PG8_MMA
#undef PG8_WAIT_V
#undef PG8_WAIT_L
#undef PG8_BAR
#undef PG8_SCHED
}
}

#define LAS __attribute__((address_space(3)))
typedef unsigned short bf16_t;
typedef short bf16x8 __attribute__((ext_vector_type(8)));
typedef short s16x4 __attribute__((ext_vector_type(4)));
typedef float f32x16 __attribute__((ext_vector_type(16)));
typedef float f32x4 __attribute__((ext_vector_type(4)));
typedef float f32x2v __attribute__((ext_vector_type(2)));
typedef unsigned u32x4 __attribute__((ext_vector_type(4)));
typedef unsigned u32x2 __attribute__((ext_vector_type(2)));
typedef __bf16 bf16x2_t __attribute__((ext_vector_type(2)));

constexpr int NB = 4, SEQ = 8192, NMETA = 16, DM = 1024, DEPTH = 4;
constexpr int LP = 8320, PADF = 112;
constexpr int MROWS = NB * LP;
constexpr int DIN = 4104, NPROJ = 4096, FFCOL = 3584;
constexpr int NSEG = 256, SEGROWS = 130;
constexpr float LOG2E = 1.4426950408889634f;
constexpr float QSCALE = 0.125f * LOG2E;
constexpr int NBLK = 65;
constexpr int NUNIT_HALF = 16 * NBLK;
constexpr int LDS_BYTES = 147456;

constexpr size_t WS_CTL = 0, CTL_BYTES = 32768;
constexpr int CW_KINF = 16, CW_KINFD = 48, CW_BAR = 4096;
constexpr size_t WS_ROPE = 32768;
constexpr size_t WS_CL = WS_ROPE + (size_t)2 * LP * 8 * 4;
constexpr size_t WS_CF = WS_CL + (size_t)MROWS * 8 * 4;
constexpr size_t WS_TOT = WS_CF + (size_t)MROWS * 8 * 4;
constexpr size_t WS_WIN = (size_t)4 << 20;
constexpr size_t WS_WOUT = WS_WIN + (size_t)DEPTH * NPROJ * DM * 2;
constexpr size_t WS_H = WS_WOUT + (size_t)DEPTH * DM * DM * 2;
constexpr size_t WS_HN = WS_H + (size_t)MROWS * DM * 4;
constexpr size_t WS_QALL = WS_HN + (size_t)MROWS * DM * 2;
constexpr size_t SZ512 = (size_t)MROWS * 512 * 2;
constexpr size_t WS_KD = WS_QALL + (size_t)MROWS * DM * 2;
constexpr size_t WS_VD = WS_KD + SZ512, WS_GD = WS_VD + SZ512, WS_KF = WS_GD + SZ512, WS_VF = WS_KF + SZ512, WS_GF = WS_VF + SZ512;
constexpr size_t WS_END = WS_GF + SZ512;
constexpr size_t WS_Y = WS_KD;
static_assert(WS_Y + (size_t)MROWS * DM * 4 <= WS_END, "y overlay");
constexpr size_t WS_RSTD = WS_TOT + 256 * 8 * 4;
static_assert(WS_RSTD + (size_t)MROWS * 4 <= WS_WIN, "ws map");

struct Args {
    const float* x; const float* meta; const float* norm_gain; const float* w_in; const float* forget_bias;
    const float* lq1; const float* lk1; const float* lq2; const float* lk2; const float* subln; const float* w_out; const float* final_gain;
    float* out; unsigned char* ws;
    float lam_init[4]; float inv_freq[8];
};

__device__ __forceinline__ int rfl(int v) { return __builtin_amdgcn_readfirstlane(v); }
__device__ __forceinline__ int opaque_tid() { int t = threadIdx.x; asm volatile("" : "+v"(t)); return t; }
__device__ __forceinline__ float wave_sum(float v) {
#pragma unroll
    for (int o = 1; o < 64; o <<= 1) v += __shfl_xor(v, o);
    return v;
}
__device__ __forceinline__ unsigned f2bf(float f) { unsigned u = __builtin_bit_cast(unsigned, f); return (u + 0x7fffu + ((u >> 16) & 1u)) >> 16; }
__device__ __forceinline__ unsigned pk2(float lo, float hi) { f32x2v v = {lo, hi}; bf16x2_t b = __builtin_convertvector(v, bf16x2_t); return __builtin_bit_cast(unsigned, b); }
__device__ __forceinline__ float bf2f(unsigned short u) { return __builtin_bit_cast(float, (unsigned)u << 16); }
__device__ __forceinline__ float swap_max(float m) { auto rr = __builtin_amdgcn_permlane32_swap(__float_as_uint(m), __float_as_uint(m), false, false); return fmaxf(__uint_as_float(rr[0]), __uint_as_float(rr[1])); }
__device__ __forceinline__ float swap_add(float m) { auto rr = __builtin_amdgcn_permlane32_swap(__float_as_uint(m), __float_as_uint(m), false, false); return __uint_as_float(rr[0]) + __uint_as_float(rr[1]); }

__device__ __forceinline__ float fadd_s(float a, float b) { float r; asm("v_add_f32_e32 %0, %1, %2" : "=v"(r) : "v"(a), "v"(b)); return r; }
__device__ __forceinline__ float max3f(float a, float b, float c) { float r; asm("v_max3_f32 %0, %1, %2, %3" : "=v"(r) : "v"(a), "v"(b), "v"(c)); return r; }

struct EpiInProj {
    static constexpr bool PERM = true, AFTER_DRAIN = false;
    bf16_t* qall; bf16_t* kd; bf16_t* vd; bf16_t* gd; bf16_t* kf; bf16_t* vf; bf16_t* gf; const float* ropec; const float* ropes; unsigned* kinf; unsigned* kinfd; const float* rstd;
    __device__ __forceinline__ void operator()(const pg8::f32x4 (&acc)[2][2][4][2], const pg8::Unit& u, int wr, int wc, int fr, int fq) const {
        const int type = u.pn >> 1, half = u.pn & 1;
        bf16_t* base; int ldc = 512; float sc = 1.f; bool rope = false, silu = false;
        switch (type) {
            case 0: base = qall; ldc = 1024; sc = QSCALE; rope = true; break;
            case 1: base = kd; rope = true; break;
            case 2: base = vd; break;
            case 3: base = gd; silu = true; break;
            case 4: base = qall + 512; ldc = 1024; sc = QSCALE; break;
            case 5: base = kf; break;
            case 6: base = vf; break;
            default: base = gf; silu = true; break;
        }
        base += 256 * half;
        if (type == 5 || type == 1) {
#pragma unroll
            for (int bj = 0; bj < 2; ++bj) { float mxa = 0.f;
#pragma unroll
                for (int ai = 0; ai < 2; ++ai)
#pragma unroll
                    for (int m = 0; m < 4; ++m)
#pragma unroll
                        for (int n = 0; n < 2; ++n)
#pragma unroll
                            for (int e = 0; e < 4; ++e) mxa = fmaxf(mxa, fabsf(acc[ai][bj][m][n][e]) * rstd[u.pm * 256 + wr * 64 + fr + ai * 128 + m * 16]);
#pragma unroll
                for (int o = 1; o < 64; o <<= 1) mxa = fmaxf(mxa, __shfl_xor(mxa, o));
                if (fr == 0 && fq == 0) atomicMax(type == 5 ? kinf + 4 * half + 2 * bj + (wc >> 1) : kinfd + 2 * half + bj, __float_as_uint(mxa)); }
        }
        const int row0 = u.pm * 256 + wr * 64 + fr, col0 = wc * 32 + 8 * fq;
        const bool dorope = rope && ((wc & 1) == 0);
        const float sgn = (fq == 0) ? -1.f : 1.f;
#pragma unroll
        for (int ai = 0; ai < 2; ++ai)
#pragma unroll
            for (int m = 0; m < 4; ++m) {
                const int row = row0 + ai * 128 + m * 16;
                const int tok = row & (SEQ - 1);
                bf16_t* rowp = base + (size_t)((row >> 13) * LP + PADF + NMETA + tok) * ldc + col0;
                const float scr = sc * rstd[row];
                f32x4 c0 = {1.f, 1.f, 1.f, 1.f}, c1 = c0, s0 = {0.f, 0.f, 0.f, 0.f}, s1 = s0;
                if (dorope) {
                    const int pos = NMETA + tok;
                    if (fq < 2) { c0 = *(const f32x4*)(ropec + pos * 8); c1 = *(const f32x4*)(ropec + pos * 8 + 4); s0 = *(const f32x4*)(ropes + pos * 8); s1 = *(const f32x4*)(ropes + pos * 8 + 4); }
                }
#pragma unroll
                for (int bj = 0; bj < 2; ++bj) {
                    f32x4 v0 = acc[ai][bj][m][0] * scr, v1 = acc[ai][bj][m][1] * scr;
                    if (dorope) {
                        f32x4 p0, p1;
#pragma unroll
                        for (int e = 0; e < 4; ++e) { p0[e] = __shfl_xor(v0[e], 16); p1[e] = __shfl_xor(v1[e], 16); }
                        v0 = v0 * c0 + (p0 * s0) * sgn; v1 = v1 * c1 + (p1 * s1) * sgn;
                    }
                    if (silu) {
#pragma unroll
                        for (int e = 0; e < 4; ++e) { v0[e] = v0[e] * __builtin_amdgcn_rcpf(1.f + __builtin_amdgcn_exp2f(-LOG2E * v0[e])); v1[e] = v1[e] * __builtin_amdgcn_rcpf(1.f + __builtin_amdgcn_exp2f(-LOG2E * v1[e])); }
                    }
                    u32x4 w; w.x = pk2(v0[0], v0[1]); w.y = pk2(v0[2], v0[3]); w.z = pk2(v1[0], v1[1]); w.w = pk2(v1[2], v1[3]);
                    *(u32x4*)(rowp + bj * 128) = w;
                }
            }
    }
};
struct EpiResid {
    static constexpr bool PERM = true, AFTER_DRAIN = false;
    bf16_t* y;
    __device__ __forceinline__ void operator()(const pg8::f32x4 (&acc)[2][2][4][2], const pg8::Unit& u, int wr, int wc, int fr, int fq) const {
        const int row0 = u.pm * 256 + wr * 64 + fr, col0 = u.pn * 256 + wc * 32 + 8 * fq;
#pragma unroll
        for (int ai = 0; ai < 2; ++ai)
#pragma unroll
            for (int m = 0; m < 4; ++m) {
                bf16_t* rp = y + (size_t)(row0 + ai * 128 + m * 16) * DM + col0;
#pragma unroll
                for (int bj = 0; bj < 2; ++bj) { const f32x4 v0 = acc[ai][bj][m][0], v1 = acc[ai][bj][m][1];
                    u32x4 w; w.x = pk2(v0[0], v0[1]); w.y = pk2(v0[2], v0[3]); w.z = pk2(v1[0], v1[1]); w.w = pk2(v1[2], v1[3]);
                    *(u32x4*)(rp + bj * 128) = w; }
            }
    }
};

constexpr int GTOK = NB * SEQ;
__device__ __forceinline__ int g_row(int b, int P) { return P >= PADF + NMETA ? b * SEQ + (P - PADF - NMETA) : (P >= PADF ? GTOK + b * NMETA + (P - PADF) : -1); }
__device__ __forceinline__ void meta_outproj(LAS unsigned char* lds, const bf16_t* __restrict__ AO, const bf16_t* __restrict__ Wt, bf16_t* __restrict__ Y) {
    const int tid = opaque_tid(), lane = tid & 63, wid = rfl(tid >> 6);
    typedef float f32x4m __attribute__((ext_vector_type(4)));
    LAS f32x4m* part = (LAS f32x4m*)lds;
    for (int blk = blockIdx.x; blk < 256; blk += gridDim.x) {
        const int rb = blk >> 6, cb = blk & 63;
        const bf16_t* ap = AO + (size_t)(GTOK + 16 * rb + (lane & 15)) * DM + 8 * (lane >> 4) + 128 * wid;
        const bf16_t* bp = Wt + (size_t)(16 * cb + (lane & 15)) * DM + 8 * (lane >> 4) + 128 * wid;
        f32x4m acc = {0.f, 0.f, 0.f, 0.f};
#pragma unroll
        for (int ks = 0; ks < 4; ++ks) { const bf16x8 av = *(const bf16x8*)(ap + 32 * ks), bv = *(const bf16x8*)(bp + 32 * ks); acc = __builtin_amdgcn_mfma_f32_16x16x32_bf16(av, bv, acc, 0, 0, 0); }
        part[wid * 64 + lane] = acc;
        __syncthreads();
        if (wid == 0) {
            f32x4m t = part[lane];
#pragma unroll
            for (int w = 1; w < 8; ++w) t = t + part[w * 64 + lane];
#pragma unroll
            for (int r = 0; r < 4; ++r) Y[(size_t)(GTOK + 16 * rb + 4 * (lane >> 4) + r) * DM + 16 * cb + (lane & 15)] = (bf16_t)(pk2(t[r], 0.f) & 0xffffu);
        }
        __syncthreads();
    }
}

__device__ __forceinline__ void meta_inproj(LAS unsigned char* lds, const bf16_t* __restrict__ H, const bf16_t* __restrict__ Wt, const EpiInProj& E) {
    const int tid = opaque_tid(), lane = tid & 63, wid = rfl(tid >> 6), blkl = wid >> 1, kh = wid & 1;
    typedef float f32x4m __attribute__((ext_vector_type(4)));
    LAS f32x4m* part = (LAS f32x4m*)lds;
    for (int base = blockIdx.x * 4; base < 1024; base += gridDim.x * 4) {
        const int blk = base + blkl, rb = blk >> 8, cb = blk & 255;
        const bf16_t* ap = H + (size_t)(GTOK + 16 * rb + (lane & 15)) * DM + 8 * (lane >> 4) + 512 * kh;
        const bf16_t* bp = Wt + (size_t)(16 * cb + (lane & 15)) * DM + 8 * (lane >> 4) + 512 * kh;
        f32x4m acc = {0.f, 0.f, 0.f, 0.f};
#pragma unroll 4
        for (int ks = 0; ks < 16; ++ks) { const bf16x8 av = *(const bf16x8*)(ap + 32 * ks), bv = *(const bf16x8*)(bp + 32 * ks); acc = __builtin_amdgcn_mfma_f32_16x16x32_bf16(av, bv, acc, 0, 0, 0); }
        part[wid * 64 + lane] = acc;
        __syncthreads();
        if (kh == 0) {
            const f32x4m t = part[wid * 64 + lane] + part[(wid + 1) * 64 + lane];
            const int n = 16 * cb + (lane & 15), type = n >> 9, cw = n & 511, i0 = 4 * (lane >> 4);
            const bool ropeblk = (type < 2) && ((cb & 3) == 0);
            const float sc = (type == 0 || type == 4) ? QSCALE : 1.f;
            float v[4], mxa = 0.f;
#pragma unroll
            for (int r = 0; r < 4; ++r) { const float kv = t[r] * E.rstd[GTOK + 16 * rb + i0 + r]; mxa = fmaxf(mxa, fabsf(kv)); v[r] = kv * sc; }
            if (type == 1 || type == 5) {
#pragma unroll
                for (int o = 1; o < 64; o <<= 1) mxa = fmaxf(mxa, __shfl_xor(mxa, o));
                const int cw0 = (16 * cb) & 511;
                if (lane == 0) atomicMax(type == 5 ? E.kinf + (cw0 >> 6) : E.kinfd + (cw0 >> 7), __float_as_uint(mxa));
            }
            if (ropeblk) {
                const int d = lane & 15;
#pragma unroll
                for (int r = 0; r < 4; ++r) { const float p = __shfl_xor(v[r], 8); const float c = E.ropec[(i0 + r) * 8 + (d & 7)], sn = E.ropes[(i0 + r) * 8 + (d & 7)]; v[r] = v[r] * c + (d < 8 ? -p : p) * sn; }
            }
            if (type == 3 || type == 7) {
#pragma unroll
                for (int r = 0; r < 4; ++r) v[r] = v[r] * __builtin_amdgcn_rcpf(1.f + __builtin_amdgcn_exp2f(-LOG2E * v[r]));
            }
            bf16_t* dst; int ldc = 512;
            switch (type) { case 0: dst = E.qall; ldc = 1024; break; case 1: dst = E.kd; break; case 2: dst = E.vd; break; case 3: dst = E.gd; break;
                            case 4: dst = E.qall + 512; ldc = 1024; break; case 5: dst = E.kf; break; case 6: dst = E.vf; break; default: dst = E.gf; break; }
#pragma unroll
            for (int r = 0; r < 4; ++r) dst[(size_t)(rb * LP + PADF + i0 + r) * ldc + cw] = (bf16_t)(pk2(v[r], 0.f) & 0xffffu);
        }
        __syncthreads();
    }
}

__device__ __forceinline__ void transpose_item(const float* W, int ldw, int K, bf16_t* WT, LAS float* scr, int kb, int nb, int srccol0, int lane, const float* gk) {
    const int k0 = 64 * kb, n0 = 32 * nb;
#pragma unroll 8
    for (int i = 0; i < 32; ++i) { const int kk = 2 * i + (lane >> 5); scr[kk * 33 + (lane & 31)] = W[(size_t)(k0 + kk) * ldw + srccol0 + (lane & 31)] * (gk ? gk[k0 + kk] : 1.0f); }
    asm volatile("s_waitcnt lgkmcnt(0)" ::: "memory");
    const int c = lane & 7;
#pragma unroll
    for (int j = 0; j < 4; ++j) { const int n = (lane >> 3) + 8 * j; const LAS float* s = scr + (8 * c) * 33 + n;
        u32x4 o; o.x = pk2(s[0 * 33], s[1 * 33]); o.y = pk2(s[2 * 33], s[3 * 33]); o.z = pk2(s[4 * 33], s[5 * 33]); o.w = pk2(s[6 * 33], s[7 * 33]);
        *(u32x4*)(WT + (size_t)(n0 + n) * K + k0 + 8 * c) = o; }
    asm volatile("s_waitcnt lgkmcnt(0)" ::: "memory");
}
__device__ __forceinline__ void prologue_phase(LAS unsigned char* lds, const Args& a) {
    const int tid = opaque_tid(), lane = tid & 63, wid = rfl(tid >> 6);
    LAS float* scr = (LAS float*)(lds + wid * 8448);
    const int gw = blockIdx.x * 8 + wid, NGW = gridDim.x * 8;
    constexpr int I_IN = 16 * 128, I_OUT = 16 * 32, I_L = I_IN + I_OUT;
    bf16_t* WIN = (bf16_t*)(a.ws + WS_WIN); bf16_t* WOUT = (bf16_t*)(a.ws + WS_WOUT);
    for (int it = gw; it < DEPTH * I_L; it += NGW) {
        const int l = it / I_L; int r = it % I_L;
        if (r < I_IN) { const int kb = r / 128, nb = r % 128; const int n0 = 32 * nb; const int src = n0 < FFCOL ? n0 : n0 + 8;
            transpose_item(a.w_in + (size_t)l * DM * DIN, DIN, DM, WIN + (size_t)l * NPROJ * DM, scr, kb, nb, src, lane, a.norm_gain + l * DM); }
        else { r -= I_IN; const int kb = r / 32, nb = r % 32;
            transpose_item(a.w_out + (size_t)l * DM * DM, DM, DM, WOUT + (size_t)l * DM * DM, scr, kb, nb, 32 * nb, lane, nullptr); }
    }
    { bf16_t* VDz = (bf16_t*)(a.ws + WS_VD); bf16_t* VFz = (bf16_t*)(a.ws + WS_VF);
      for (int i = blockIdx.x * 512 + tid; i < NB * PADF * 64 * 2; i += gridDim.x * 512) {
          const int arr = i / (NB * PADF * 64), rem = i % (NB * PADF * 64), rowi = rem >> 6, ch = rem & 63, bz = rowi / PADF, pz = rowi % PADF;
          *(u32x4*)((arr ? VFz : VDz) + (size_t)(bz * LP + pz) * 512 + ch * 8) = (u32x4){0u, 0u, 0u, 0u}; } }
    float* rc = (float*)(a.ws + WS_ROPE); float* rs = rc + LP * 8;
    for (int i = blockIdx.x * 512 + tid; i < LP * 8; i += gridDim.x * 512) {
        const int pos = i >> 3, f = i & 7;
        const float ang = (float)pos * a.inv_freq[f];
        double rev = (double)ang * 0.15915494309189533577; rev -= floor(rev);
        rc[i] = __builtin_amdgcn_cosf((float)rev); rs[i] = __builtin_amdgcn_sinf((float)rev);
    }
}

__device__ __forceinline__ float dppf(float v, const int ctrl_sel) {
    const int x = __float_as_int(v); int r;
    if (ctrl_sel == 0) r = __builtin_amdgcn_update_dpp(x, x, 0xB1, 0xF, 0xF, true);
    else if (ctrl_sel == 1) r = __builtin_amdgcn_update_dpp(x, x, 0x4E, 0xF, 0xF, true);
    else if (ctrl_sel == 2) r = __builtin_amdgcn_update_dpp(x, x, 0x141, 0xF, 0xF, true);
    else r = __builtin_amdgcn_update_dpp(x, x, 0x140, 0xF, 0xF, true);
    return __int_as_float(r);
}
__device__ __forceinline__ float wsum(float v) {
    v += dppf(v, 0); v += dppf(v, 1); v += dppf(v, 2); v += dppf(v, 3);
    { auto rr = __builtin_amdgcn_permlane16_swap(__float_as_uint(v), __float_as_uint(v), false, false); v = __uint_as_float(rr[0]) + __uint_as_float(rr[1]); }
    return swap_add(v);
}
__device__ __forceinline__ void norm_phase(LAS unsigned char* lds, const Args& a, int layer) {
    const int tid = opaque_tid(), lane = tid & 63, wid = rfl(tid >> 6);
    LAS float* lf = (LAS float*)lds;
    bf16_t* H = (bf16_t*)(a.ws + WS_H); const bf16_t* Y = (const bf16_t*)(a.ws + WS_Y); float* RSTD = (float*)(a.ws + WS_RSTD); float* CL = (float*)(a.ws + WS_CL); float* TOT = (float*)(a.ws + WS_TOT);
    const float* gain = a.norm_gain + layer * DM;
    const float* wff = a.w_in + (size_t)layer * DM * DIN + FFCOL;
    LAS f32x4* wl = (LAS f32x4*)(lds + 8192);
    for (int k = tid; k < DM; k += 512) { const float gk = gain[k]; const float* p = wff + (size_t)k * DIN; const int jj = k >> 8, ln = (k & 255) >> 2, e = k & 3;
        wl[((jj * 4 + e) * 2 + 0) * 64 + ln] = *(const f32x4*)p * gk; wl[((jj * 4 + e) * 2 + 1) * 64 + ln] = *(const f32x4*)(p + 4) * gk; }
    __syncthreads();
    const float fb = a.forget_bias[layer * 8 + (lane & 7)];
    for (int seg = blockIdx.x; seg < NSEG; seg += gridDim.x) {
        const int row0 = seg * SEGROWS;
        f32x4 nh[4], ny[4];
#define NORM_LOAD(r_) do { const int row_ = row0 + (r_), b_ = row_ / LP, P_ = row_ % LP; \
            if (layer == 0) { \
                if (P_ < PADF) { _Pragma("unroll") for (int jj = 0; jj < 4; ++jj) nh[jj] = (f32x4){0.f, 0.f, 0.f, 0.f}; } \
                else { const float* src_ = (P_ < PADF + NMETA) ? a.meta + (size_t)(P_ - PADF) * DM : a.x + ((size_t)b_ * SEQ + (P_ - PADF - NMETA)) * DM; \
                    _Pragma("unroll") for (int jj = 0; jj < 4; ++jj) nh[jj] = *(const f32x4*)(src_ + 256 * jj + 4 * lane); } \
                _Pragma("unroll") for (int jj = 0; jj < 4; ++jj) ny[jj] = (f32x4){0.f, 0.f, 0.f, 0.f}; \
            } else { \
                const int gr_ = g_row(b_, P_); const size_t yr_ = (size_t)(gr_ < 0 ? 0 : gr_); \
                _Pragma("unroll") for (int jj = 0; jj < 4; ++jj) { u32x2 hb_ = *(const u32x2*)(H + yr_ * DM + 256 * jj + 4 * lane); u32x2 yb_ = *(const u32x2*)(Y + yr_ * DM + 256 * jj + 4 * lane); if (gr_ < 0) { hb_ = (u32x2){0u, 0u}; yb_ = hb_; } \
                    nh[jj] = (f32x4){__uint_as_float(hb_.x << 16), __uint_as_float(hb_.x & 0xffff0000u), __uint_as_float(hb_.y << 16), __uint_as_float(hb_.y & 0xffff0000u)}; \
                    ny[jj] = (f32x4){__uint_as_float(yb_.x << 16), __uint_as_float(yb_.x & 0xffff0000u), __uint_as_float(yb_.y << 16), __uint_as_float(yb_.y & 0xffff0000u)}; } \
            } } while (0)
        NORM_LOAD(wid);
        for (int r = wid; r < SEGROWS; r += 8) {
            const int row = row0 + r, P = row % LP, grw = g_row(row / LP, P);
            f32x4 v[4];
#pragma unroll
            for (int jj = 0; jj < 4; ++jj) v[jj] = nh[jj] + ny[jj];
            if (r + 8 < SEGROWS) NORM_LOAD(r + 8);
#pragma unroll
            for (int jj = 0; jj < 4; ++jj) { u32x2 o; o.x = pk2(v[jj].x, v[jj].y); o.y = pk2(v[jj].z, v[jj].w); if (grw >= 0) *(u32x2*)(H + (size_t)grw * DM + 256 * jj + 4 * lane) = o; }
            float ss = 0.f, acc[8];
#pragma unroll
            for (int c = 0; c < 8; ++c) acc[c] = 0.f;
#pragma unroll
            for (int jj = 0; jj < 4; ++jj) {
                ss += (v[jj].x * v[jj].x + v[jj].y * v[jj].y) + (v[jj].z * v[jj].z + v[jj].w * v[jj].w);
#pragma unroll
                for (int e = 0; e < 4; ++e) { const float xv = v[jj][e]; const f32x4 w0 = wl[((jj * 4 + e) * 2 + 0) * 64 + lane], w1 = wl[((jj * 4 + e) * 2 + 1) * 64 + lane];
#pragma unroll
                    for (int c = 0; c < 4; ++c) { acc[c] += xv * w0[c]; acc[4 + c] += xv * w1[c]; } }
            }
            ss = wsum(ss);
#pragma unroll
            for (int c = 0; c < 8; ++c) acc[c] = wsum(acc[c]);
            const float rstd = 1.0f / sqrtf(ss * (1.0f / DM) + 1e-6f);
            if (lane == 0 && grw >= 0) RSTD[grw] = rstd;
            const int lc = lane & 7;
            float z = lc == 0 ? acc[0] : lc == 1 ? acc[1] : lc == 2 ? acc[2] : lc == 3 ? acc[3] : lc == 4 ? acc[4] : lc == 5 ? acc[5] : lc == 6 ? acc[6] : acc[7];
            z = z * rstd + fb;
            float lfv = fminf(z, 0.f) - log1pf(expf(-fabsf(z)));
            if (P < PADF) lfv = 0.f;
            if (lane < 8) lf[r * 8 + lane] = lfv;
        }
#undef NORM_LOAD
        __syncthreads();
        if (wid == 0) {
            const int c = lane & 7, ch = lane >> 3;
            float vals[17], s = 0.f;
#pragma unroll
            for (int i = 0; i < 17; ++i) { const int r = ch * 17 + i; s += (r < SEGROWS) ? lf[r * 8 + c] : 0.f; vals[i] = s; }
            lf[1152 + lane] = s;
            asm volatile("s_waitcnt lgkmcnt(0)" ::: "memory");
            float off = 0.f;
#pragma unroll
            for (int k = 0; k < 7; ++k) off += (k < ch) ? lf[1152 + k * 8 + c] : 0.f;
#pragma unroll
            for (int i = 0; i < 17; ++i) { const int r = ch * 17 + i; if (r < SEGROWS) CL[(size_t)(row0 + r) * 8 + c] = vals[i] + off; }
            if (ch == 7) TOT[seg * 8 + c] = vals[16] + off;
        }
        __syncthreads();
    }
}
__device__ __forceinline__ void cumfix_phase(LAS unsigned char* lds, const Args& a) {
    const int tid = opaque_tid();
    LAS float* sc = (LAS float*)lds;
    const float* CL = (const float*)(a.ws + WS_CL); const float* TOT = (const float*)(a.ws + WS_TOT); float* CF = (float*)(a.ws + WS_CF);
    for (int seg = blockIdx.x; seg < NSEG; seg += gridDim.x) {
        const int b = seg >> 6, s = seg & 63, part = tid >> 3, c = tid & 7;
        sc[part * 8 + c] = (part < s) ? TOT[(b * 64 + part) * 8 + c] : 0.f;
        __syncthreads();
        if (tid < 8) { float t = 0.f; for (int p = 0; p < 64; ++p) t += sc[p * 8 + tid]; sc[512 + tid] = t; }
        __syncthreads();
        for (int i = tid; i < SEGROWS * 8; i += 512) CF[(size_t)seg * SEGROWS * 8 + i] = CL[(size_t)seg * SEGROWS * 8 + i] + sc[512 + (i & 7)];
        __syncthreads();
    }
}
__device__ __forceinline__ void final_phase(const Args& a) {
    const int tid = opaque_tid(), lane = tid & 63, wid = rfl(tid >> 6);
    const bf16_t* H = (const bf16_t*)(a.ws + WS_H); const bf16_t* Y = (const bf16_t*)(a.ws + WS_Y);
    f32x4 g4[4];
#pragma unroll
    for (int jj = 0; jj < 4; ++jj) g4[jj] = *(const f32x4*)(a.final_gain + 256 * jj + 4 * lane);
    for (int orow = blockIdx.x * 8 + wid; orow < NB * SEQ; orow += gridDim.x * 8) {
        const int b = orow / SEQ, s = orow % SEQ; const size_t row = (size_t)b * LP + PADF + NMETA + s;
        f32x4 v[4]; float ss = 0.f;
#pragma unroll
        for (int jj = 0; jj < 4; ++jj) { const u32x2 yb_ = *(const u32x2*)(Y + (size_t)orow * DM + 256 * jj + 4 * lane); const u32x2 hb_ = *(const u32x2*)(H + (size_t)orow * DM + 256 * jj + 4 * lane); v[jj] = (f32x4){__uint_as_float(hb_.x << 16), __uint_as_float(hb_.x & 0xffff0000u), __uint_as_float(hb_.y << 16), __uint_as_float(hb_.y & 0xffff0000u)} + (f32x4){__uint_as_float(yb_.x << 16), __uint_as_float(yb_.x & 0xffff0000u), __uint_as_float(yb_.y << 16), __uint_as_float(yb_.y & 0xffff0000u)}; ss += (v[jj].x * v[jj].x + v[jj].y * v[jj].y) + (v[jj].z * v[jj].z + v[jj].w * v[jj].w); }
        ss = wsum(ss);
        const float rstd = 1.0f / sqrtf(ss * (1.0f / DM) + 1e-6f);
#pragma unroll
        for (int jj = 0; jj < 4; ++jj) *(f32x4*)(a.out + (size_t)orow * DM + 256 * jj + 4 * lane) = v[jj] * rstd * g4[jj];
    }
}

#define XB_TMO      128
#define XB_XCNT(j)  (256  + 64 * (j))
#define XB_XSUB(j)  (1280 + 64 * (j))
#define XB_XGEN(j)  (2304 + 64 * (j))
#define XB_TOP      3328
#define XB_TOPGEN   3392
#define XCD_BAR_WORDS 3456
#define XB_SPIN_CAP (1u << 18)

__device__ __forceinline__ unsigned xb_ld(unsigned* p)              { return __hip_atomic_load(p, __ATOMIC_RELAXED, __HIP_MEMORY_SCOPE_AGENT); }
__device__ __forceinline__ unsigned xb_add(unsigned* p, unsigned v) { return __hip_atomic_fetch_add(p, v, __ATOMIC_RELAXED, __HIP_MEMORY_SCOPE_AGENT); }
__device__ __forceinline__ unsigned xb_xcc_id() { return (unsigned)__builtin_amdgcn_s_getreg((3 << 11) | 20) & 0xFu; }
#define XB_SPIN(cond, bar) do { unsigned _sp = 0; while (cond) { __builtin_amdgcn_s_sleep(1); \
    if ((++_sp & 255u) == 0u) { if (xb_ld(&(bar)[XB_TMO])) break; if (_sp > XB_SPIN_CAP) { atomicAdd(&(bar)[XB_TMO], 1u); break; } } } } while (0)

struct XcdBarrier {
    unsigned* bar; unsigned x;
    volatile LAS unsigned* st;
};

__device__ __forceinline__ XcdBarrier xcd_barrier_post(unsigned* bar, volatile LAS unsigned* st) {
    XcdBarrier b; b.bar = bar; b.x = xb_xcc_id(); b.st = st;
    if (threadIdx.x == 0) (void)xb_add(&bar[XB_XCNT(b.x)], 1u);
    return b;
}
__device__ __forceinline__ void xcd_barrier_complete(unsigned* bar, unsigned x, unsigned& nloc, unsigned& nx) {
    const unsigned G = gridDim.x * gridDim.y * gridDim.z;
    unsigned sum, cnt, mine, sp = 0u;
    for (;;) {
        sum = 0u; cnt = 0u; mine = 0u;
#pragma unroll
        for (unsigned j = 0; j < 16; ++j) { const unsigned c = xb_ld(&bar[XB_XCNT(j)]); sum += c; cnt += (c > 0u) ? 1u : 0u; mine = (j == x) ? c : mine; }
        if (sum == G) break;
        __builtin_amdgcn_s_sleep(1);
        if ((++sp & 255u) == 0u) { if (xb_ld(&bar[XB_TMO])) break; if (sp > XB_SPIN_CAP) { atomicAdd(&bar[XB_TMO], 1u); break; } }
    }
    nloc = mine > 0u ? mine : 1u; nx = cnt > 0u ? cnt : 1u;
}

__device__ __forceinline__ void xcd_barrier(const XcdBarrier& b) {
    asm volatile("s_waitcnt vmcnt(0)" ::: "memory");
    __syncthreads();
    if (threadIdx.x == 0) {
        unsigned* bar = b.bar;
        __builtin_amdgcn_s_waitcnt(0);
        unsigned nloc = b.st[0], nx = b.st[1];
        if (nloc == 0u) { xcd_barrier_complete(bar, b.x, nloc, nx); b.st[0] = nloc; b.st[1] = nx; }
        const unsigned old = xb_add(&bar[XB_XSUB(b.x)], 1u);
        const unsigned gen = old / nloc;
        if (old + 1u == (gen + 1u) * nloc) {
            __builtin_amdgcn_fence(__ATOMIC_RELEASE, "agent");
            asm volatile("s_waitcnt vmcnt(0)" ::: "memory");
            const unsigned og = xb_add(&bar[XB_TOP], 1u);
            const unsigned tg = og / nx;
            if (og + 1u == (tg + 1u) * nx) xb_add(&bar[XB_TOPGEN], 1u);
            else XB_SPIN(xb_ld(&bar[XB_TOPGEN]) == tg, bar);
            __builtin_amdgcn_fence(__ATOMIC_ACQUIRE, "agent");
            xb_add(&bar[XB_XGEN(b.x)], 1u);
            asm volatile("s_waitcnt vmcnt(0)" ::: "memory");
        } else {
            XB_SPIN(xb_ld(&bar[XB_XGEN(b.x)]) == gen, bar);
            __builtin_amdgcn_fence(__ATOMIC_ACQUIRE, "agent");
            asm volatile("s_waitcnt vmcnt(0)" ::: "memory");
        }
    }
    __syncthreads();
}

constexpr int ATT_CK = 131072, ATT_XCH = 0, ATT_UNITW = 133120;
__device__ __forceinline__ unsigned offb(unsigned row, unsigned ch) { return 256u * row + 16u * (ch ^ (((row & 3u) << 2) | ((row >> 2) & 3u))); }
__device__ __forceinline__ unsigned tr_addr(unsigned lane, unsigned cb, unsigned ks, unsigned t) {
    const unsigned h = lane >> 5, blk = (lane >> 4) & 1, q = (lane & 15) >> 2, p = lane & 3;
    return offb(16 * ks + 8 * h + 4 * t + q, 4 * cb + 2 * blk + (p >> 1)) + 8 * (p & 1);
}
__device__ __forceinline__ s16x4 vtr(LAS const unsigned char* p) { typedef short v4i16_t __attribute__((ext_vector_type(4))); return __builtin_bit_cast(s16x4, __builtin_amdgcn_ds_read_tr16_b64_v4i16((LAS v4i16_t*)p)); }
#define MFMA32(a, b, c) __builtin_amdgcn_mfma_f32_32x32x16_bf16((a), (b), (c), 0, 0, 0)

template <bool FOX>
__device__ __forceinline__ void attn_unit(LAS unsigned char* lds, int b, int g, int j, const bf16_t* __restrict__ QALL, const bf16_t* __restrict__ K, const bf16_t* __restrict__ V,
                                          const bf16_t* __restrict__ G, const float* __restrict__ CF, const float* __restrict__ subln, float lam, float oml, float kinf, bf16_t* __restrict__ AO) {
    const int tid = opaque_tid(), lane = tid & 63, wid = rfl(tid >> 6), stream = wid >> 2, wq = wid & 3, l31 = lane & 31, hi = lane >> 5;
    constexpr int NCB = FOX ? 2 : 4;
    const size_t rowb = (size_t)b * LP;
    const int q0 = j * 128, qloc128 = 32 * wq + l31, qrow = q0 + qloc128;
    const int tq = 2 * j + (wq >> 1);
    const int NT = 2 * j + 1;
    bf16x8 qf[4];
    { const bf16_t* qp = QALL + (rowb + qrow) * DM + (FOX ? 512 : 0) + 128 * g + 64 * stream + 8 * hi;
#pragma unroll
      for (int s = 0; s < 4; ++s) qf[s] = *(const bf16x8*)(qp + 16 * s); }
    float cq2 = 0.f;
    if (FOX) cq2 = CF[(rowb + qrow) * 8 + 2 * g + stream] * LOG2E;
    const int r4 = lane >> 4, c16 = lane & 15;
    const int chA = c16 ^ ((r4 << 2) | ((2 * wid) & 3)), chB = c16 ^ ((r4 << 2) | ((2 * wid + 1) & 3));
    const bf16_t* kgA = K + (rowb + 8 * wid + r4) * 512 + 128 * g + 8 * chA;
    const bf16_t* kgB = K + (rowb + 8 * wid + 4 + r4) * 512 + 128 * g + 8 * chB;
    const bf16_t* vgA = V + (rowb + 8 * wid + r4) * 512 + 128 * g + 8 * chA;
    const bf16_t* vgB = V + (rowb + 8 * wid + 4 + r4) * 512 + 128 * g + 8 * chB;
    const float* cfg = CF + (rowb + lane) * 8 + 2 * g + (wid & 1);
#define ATT_DMA(t, sb) do { const size_t ro_ = (size_t)(64 * (t)) * 512; LAS unsigned char* d_ = lds + (sb) * 32768 + wid * 2048; \
        __builtin_amdgcn_global_load_lds((const unsigned*)(kgA + ro_), (LAS unsigned*)(d_), 16, 0, 0); \
        __builtin_amdgcn_global_load_lds((const unsigned*)(kgB + ro_), (LAS unsigned*)(d_ + 1024), 16, 0, 0); \
        __builtin_amdgcn_global_load_lds((const unsigned*)(vgA + ro_), (LAS unsigned*)(d_ + 16384), 16, 0, 0); \
        __builtin_amdgcn_global_load_lds((const unsigned*)(vgB + ro_), (LAS unsigned*)(d_ + 16384 + 1024), 16, 0, 0); \
        if (FOX) __builtin_amdgcn_global_load_lds((const unsigned*)(cfg + (size_t)(64 * (t)) * 8), (LAS unsigned*)(lds + ATT_CK + (sb) * 512 + (wid & 1) * 256), 4, 0, 0); } while (0)
#define ATT_WAIT_BAR(pending) do { if (pending) { if (FOX) asm volatile("s_waitcnt vmcnt(5) lgkmcnt(0)\n\ts_barrier" ::: "memory"); else asm volatile("s_waitcnt vmcnt(4) lgkmcnt(0)\n\ts_barrier" ::: "memory"); } \
        else asm volatile("s_waitcnt vmcnt(0) lgkmcnt(0)\n\ts_barrier" ::: "memory"); } while (0)
    const unsigned krow = (l31 & ~12u) | ((l31 & 4u) << 1) | ((l31 & 8u) >> 1);
    unsigned koff[4];
#pragma unroll
    for (int s = 0; s < 4; ++s) koff[s] = offb(krow, 8 * stream + 2 * s + hi);
    unsigned voff[NCB][2];
#pragma unroll
    for (int cb = 0; cb < NCB; ++cb)
#pragma unroll
        for (int t = 0; t < 2; ++t) voff[cb][t] = 16384u + tr_addr(lane, FOX ? 2 * stream + cb : cb, 0, t);
    f32x16 o[NCB];
#pragma unroll
    for (int cb = 0; cb < NCB; ++cb)
#pragma unroll
        for (int r = 0; r < 16; ++r) o[cb][r] = 0.f;
    float lsum = 0.f;
    const int qloc64 = 32 * (wq & 1) + l31;

    constexpr float THR = 96.0f, SKIP_T = 40.0f;
    float ub = 0.f, qb;
    {
        float q1 = 0.f;
#pragma unroll
        for (int s = 0; s < 4; ++s)
#pragma unroll
            for (int e = 0; e < 8; ++e) q1 += fabsf(bf2f((unsigned short)qf[s][e]));
        q1 = swap_add(q1);
        qb = q1 * kinf * 1.01f;
        if (FOX) ub = qb + cq2 + SKIP_T;
    }
    bool needmax = true;
    volatile LAS int* flags = (volatile LAS int*)(lds + ATT_UNITW + 64);
    int t = FOX ? NT : 1;
    ATT_DMA(t, 0);
    { const int t1_ = FOX ? t - 1 : t + 1; const bool h1_ = FOX ? (t1_ >= 1) : (t1_ <= NT); if (h1_) ATT_DMA(t1_, 1); ATT_WAIT_BAR(h1_); }
    bool wmore = (tq >= 1), first = true;
    float mref = 0.f;
    f32x16 negm;
#pragma unroll
    for (int r = 0; r < 16; ++r) negm[r] = 0.f;
    bf16x8 pf[4];
#pragma unroll
    for (int s = 0; s < 4; ++s) pf[s] = (bf16x8){0, 0, 0, 0, 0, 0, 0, 0};
#define ATT_SB() __builtin_amdgcn_sched_barrier(0)
#define ATT_VRD(arr, ks) do { _Pragma("unroll") for (int cb = 0; cb < NCB; ++cb) { arr[cb][0] = vtr(vbp_ + voff[cb][0] + 4096 * (ks)); arr[cb][1] = vtr(vbp_ + voff[cb][1] + 4096 * (ks)); } } while (0)
#define ATT_MM(arr, ks) do { _Pragma("unroll") for (int cb = 0; cb < NCB; ++cb) { const bf16x8 vf = {arr[cb][0][0], arr[cb][0][1], arr[cb][0][2], arr[cb][0][3], arr[cb][1][0], arr[cb][1][1], arr[cb][1][2], arr[cb][1][3]}; o[cb] = MFMA32(vf, pf[ks], o[cb]); } } while (0)
#define ATT_EXPCH(S, B, DST) do { _Pragma("unroll") for (int r = (B); r < (B) + 8; r += 2) { S[r] = __builtin_amdgcn_exp2f(S[r]); S[r + 1] = __builtin_amdgcn_exp2f(S[r + 1]); ps2.x = fadd_s(ps2.x, S[r]); ps2.y = fadd_s(ps2.y, S[r + 1]); } \
        u32x4 w_; w_.x = pk2(S[B], S[(B) + 1]); w_.y = pk2(S[(B) + 2], S[(B) + 3]); w_.z = pk2(S[(B) + 4], S[(B) + 5]); w_.w = pk2(S[(B) + 6], S[(B) + 7]); DST = __builtin_bit_cast(bf16x8, w_); asm volatile("" : "+v"(DST), "+v"(ps2)); } while (0)
    int pbuf = 0, buf = 0;
    for (;;) {
        const int tn = FOX ? t - 1 : t + 1, tn2 = FOX ? t - 2 : t + 2;
        const bool have_next = FOX ? (tn >= 1) : (tn <= NT), have_next2 = FOX ? (tn2 >= 1) : (tn2 <= NT);
        const int nbuf = (buf + 1) & 3;
        const bool act = (t <= tq) && wmore;
        LAS const unsigned char* vbp_ = lds + pbuf * 32768;
        LAS const unsigned char* kb = lds + buf * 32768;
        s16x4 va[NCB][2];
        f32x16 s0, s1;
        float ckfirst = 0.f, alpha_o = 1.f; bool resc = false;
        if (act) {
            bf16x8 kf[8];
#pragma unroll
            for (int s = 0; s < 4; ++s) { kf[2 * s] = *(LAS const bf16x8*)(kb + koff[s]); kf[2 * s + 1] = *(LAS const bf16x8*)(kb + koff[s] + 8192); }
            if (have_next2) ATT_DMA(tn2, (buf + 2) & 3);
            if (FOX) {
                LAS const float* ck = (LAS const float*)(lds + ATT_CK + buf * 512) + 64 * stream;
                ckfirst = ck[0] * LOG2E;
                ck += 8 * hi;
                const float cqm = cq2 - mref;
#pragma unroll
                for (int rr = 0; rr < 2; ++rr) {
                    const f32x4 a0 = *(LAS const f32x4*)(ck + 16 * rr), a1 = *(LAS const f32x4*)(ck + 16 * rr + 4), b0 = *(LAS const f32x4*)(ck + 32 + 16 * rr), b1 = *(LAS const f32x4*)(ck + 32 + 16 * rr + 4);
#pragma unroll
                    for (int e = 0; e < 4; ++e) { s0[8 * rr + e] = cqm - LOG2E * a0[e]; s0[8 * rr + 4 + e] = cqm - LOG2E * a1[e]; s1[8 * rr + e] = cqm - LOG2E * b0[e]; s1[8 * rr + 4 + e] = cqm - LOG2E * b1[e]; }
                }
                ATT_SB();
                s0 = MFMA32(kf[0], qf[0], s0); s1 = MFMA32(kf[1], qf[0], s1);
            } else {
                ATT_SB();
                s0 = MFMA32(kf[0], qf[0], negm); s1 = MFMA32(kf[1], qf[0], negm);
            }
#pragma unroll
            for (int s = 1; s < 4; ++s) { s0 = MFMA32(kf[2 * s], qf[s], s0); s1 = MFMA32(kf[2 * s + 1], qf[s], s1); }
        } else {
            if (have_next2) ATT_DMA(tn2, (buf + 2) & 3);
#pragma unroll
            for (int r = 0; r < 16; ++r) { s0[r] = -INFINITY; s1[r] = -INFINITY; }
        }
        ATT_VRD(va, 0);
        ATT_SB();
        if (t == 1) {
#pragma unroll
            for (int r = 0; r < 16; ++r) s0[r] = -INFINITY;
#pragma unroll
            for (int r = 0; r < 8; ++r) s1[r] = -INFINITY;
        }
        if (FOX && t == tq) {
#pragma unroll
            for (int r = 0; r < 16; ++r) { const int kl = 16 * (r >> 3) + 8 * hi + (r & 7); if (kl > qloc64) s0[r] = -INFINITY; if (kl + 32 > qloc64) s1[r] = -INFINITY; }
        }
        float mx = 0.f; bool upd = false;
        if (needmax) {
            float mxa = max3f(s0[0], s0[1], s1[0]), mxb = max3f(s0[2], s0[3], s1[1]);
            mxa = max3f(mxa, s1[2], s1[3]);
#pragma unroll
            for (int r = 4; r < 16; r += 4) { mxa = max3f(mxa, s0[r], s0[r + 1]); mxb = max3f(mxb, s0[r + 2], s0[r + 3]); mxa = max3f(mxa, s1[r], s1[r + 1]); mxb = max3f(mxb, s1[r + 2], s1[r + 3]); }
            mx = swap_max(fmaxf(mxa, mxb));
            upd = (first && act) || __any(mx > THR);
        }
        if (upd) {
            const float dl = first ? mx : fmaxf(mx, 0.f);
            alpha_o = __builtin_amdgcn_exp2f(-dl); resc = !first;
            mref += dl;
#pragma unroll
            for (int r = 0; r < 16; ++r) { s0[r] -= dl; s1[r] -= dl; }
            lsum *= alpha_o;
            if (!FOX) {
#pragma unroll
                for (int r = 0; r < 16; ++r) negm[r] = -mref;
            }
            first = false;
            needmax = __any(qb - mref > THR) != 0;
        }
        ATT_SB();
        f32x2v ps2 = {0.f, 0.f};
        ATT_MM(va, 0); ATT_VRD(va, 1); ATT_EXPCH(s0, 0, pf[0]); ATT_SB();
        ATT_MM(va, 1); ATT_VRD(va, 2); ATT_EXPCH(s0, 8, pf[1]); ATT_SB();
        ATT_MM(va, 2); ATT_VRD(va, 3); ATT_EXPCH(s1, 0, pf[2]); ATT_SB();
        ATT_MM(va, 3); ATT_EXPCH(s1, 8, pf[3]); ATT_SB();
        lsum += ps2.x + ps2.y;
        if (resc) {
#pragma unroll
            for (int cb = 0; cb < NCB; ++cb)
#pragma unroll
                for (int r = 0; r < 16; ++r) o[cb][r] *= alpha_o;
        }
        pbuf = buf;
        if (FOX && act) wmore = __any(ub - mref > ckfirst) != 0;
        bool cont = have_next;
        if (FOX) { if (lane == 0) flags[buf * 8 + wid] = wmore ? 1 : 0; }
        ATT_WAIT_BAR(have_next2);
        if (FOX && cont) { int any_ = 0;
#pragma unroll
            for (int w8 = 0; w8 < 8; ++w8) any_ |= flags[buf * 8 + w8];
            cont = rfl(any_) != 0; }
        if (!cont) break;
        t = tn; buf = nbuf;
    }
    u32x2 gpre[NCB][4];
#pragma unroll
    for (int cb = 0; cb < NCB; ++cb)
#pragma unroll
        for (int gq = 0; gq < 4; ++gq) gpre[cb][gq] = (u32x2){0u, 0u};
    if (FOX || stream == 0) {
        const bf16_t* gp_ = G + (rowb + qrow) * 512 + 128 * g + (FOX ? 64 * stream : 0) + 4 * hi;
#pragma unroll
        for (int cb = 0; cb < NCB; ++cb)
#pragma unroll
            for (int gq = 0; gq < 4; ++gq) gpre[cb][gq] = *(const u32x2*)(gp_ + 32 * cb + 8 * gq);
    }
    { LAS const unsigned char* vbp_ = lds + pbuf * 32768; s16x4 va[NCB][2];
        ATT_VRD(va, 0); ATT_SB();
        ATT_MM(va, 0); ATT_VRD(va, 1); ATT_SB();
        ATT_MM(va, 1); ATT_VRD(va, 2); ATT_SB();
        ATT_MM(va, 2); ATT_VRD(va, 3); ATT_SB();
        ATT_MM(va, 3); ATT_SB(); }
#undef ATT_SB
#undef ATT_VRD
#undef ATT_MM
#undef ATT_EXPCH
    if (!FOX) __syncthreads();
    lsum = swap_add(lsum);
    const float invl = 1.0f / lsum;
    int qrow_e = qrow; asm volatile("" : "+v"(qrow_e));
    const int grow_i = g_row(b, qrow_e);
    const size_t grow = (size_t)(grow_i < 0 ? MROWS - 1 : grow_i);
    if (FOX) {
        const int colb = 128 * g + 64 * stream;
#pragma unroll
        for (int cb = 0; cb < 2; ++cb)
#pragma unroll
            for (int gq = 0; gq < 4; ++gq) {
                const int d0 = 32 * cb + 8 * gq + 4 * hi;
                const u32x2 gt = gpre[cb][gq];
                float v0 = o[cb][4 * gq] * invl * bf2f((unsigned short)(gt.x & 0xffff)), v1 = o[cb][4 * gq + 1] * invl * bf2f((unsigned short)(gt.x >> 16));
                float v2 = o[cb][4 * gq + 2] * invl * bf2f((unsigned short)(gt.y & 0xffff)), v3 = o[cb][4 * gq + 3] * invl * bf2f((unsigned short)(gt.y >> 16));
                u32x2 w; w.x = pk2(v0, v1); w.y = pk2(v2, v3);
                *(u32x2*)(AO + grow * DM + 512 + colb + d0) = w;
            }
    } else {
        LAS float* xch = (LAS float*)(lds + ATT_XCH) + wq * 4096 + lane;
        if (stream == 1) {
#pragma unroll
            for (int cb = 0; cb < NCB; ++cb)
#pragma unroll
                for (int r = 0; r < 16; ++r) xch[(cb * 16 + r) * 64] = o[cb][r] * invl;
        }
        __syncthreads();
        if (stream == 0) {
            float ss = 0.f;
#pragma unroll
            for (int cb = 0; cb < NCB; ++cb)
#pragma unroll
                for (int r = 0; r < 16; ++r) { const float v = o[cb][r] * invl - lam * xch[(cb * 16 + r) * 64]; o[cb][r] = v; ss += v * v; }
            ss = swap_add(ss);
            const float rs = oml / sqrtf(ss * (1.0f / 128.0f) + 1e-5f);
#pragma unroll
            for (int cb = 0; cb < NCB; ++cb)
#pragma unroll
                for (int gq = 0; gq < 4; ++gq) {
                    const int d0 = 32 * cb + 8 * gq + 4 * hi;
                    const f32x4 sg = *(const f32x4*)(subln + d0);
                    const u32x2 gt = gpre[cb][gq];
                    float v0 = o[cb][4 * gq] * rs * sg[0] * bf2f((unsigned short)(gt.x & 0xffff)), v1 = o[cb][4 * gq + 1] * rs * sg[1] * bf2f((unsigned short)(gt.x >> 16));
                    float v2 = o[cb][4 * gq + 2] * rs * sg[2] * bf2f((unsigned short)(gt.y & 0xffff)), v3 = o[cb][4 * gq + 3] * rs * sg[3] * bf2f((unsigned short)(gt.y >> 16));
                    u32x2 w; w.x = pk2(v0, v1); w.y = pk2(v2, v3);
                    *(u32x2*)(AO + grow * DM + 128 * g + d0) = w;
                }
        }
    }
}

__device__ __forceinline__ void attn_phase(LAS unsigned char* lds, const Args& a, int layer, unsigned* counters) {
    const int tid = opaque_tid(), lane = tid & 63;
    const bf16_t* QALL = (const bf16_t*)(a.ws + WS_QALL); bf16_t* AO = (bf16_t*)(a.ws + WS_HN);
    float kinf8[8], kinfd4[4];
#pragma unroll
    for (int i = 0; i < 4; ++i) kinfd4[i] = __uint_as_float(__hip_atomic_load((unsigned*)(a.ws + WS_CTL) + CW_KINFD + layer * 4 + i, __ATOMIC_RELAXED, __HIP_MEMORY_SCOPE_AGENT));
#pragma unroll
    for (int i = 0; i < 8; ++i) kinf8[i] = __uint_as_float(__hip_atomic_load((unsigned*)(a.ws + WS_CTL) + CW_KINF + layer * 8 + i, __ATOMIC_RELAXED, __HIP_MEMORY_SCOPE_AGENT));
    const bf16_t* KD = (const bf16_t*)(a.ws + WS_KD); const bf16_t* VD = (const bf16_t*)(a.ws + WS_VD); const bf16_t* GD = (const bf16_t*)(a.ws + WS_GD);
    const bf16_t* KF = (const bf16_t*)(a.ws + WS_KF); const bf16_t* VF = (const bf16_t*)(a.ws + WS_VF); const bf16_t* GF = (const bf16_t*)(a.ws + WS_GF);
    const float* CF = (const float*)(a.ws + WS_CF);
    const float d1 = wave_sum(a.lq1[layer * 64 + lane] * a.lk1[layer * 64 + lane]), d2 = wave_sum(a.lq2[layer * 64 + lane] * a.lk2[layer * 64 + lane]);
    const float lam_init = a.lam_init[layer];
    const float lam = expf(d1) - expf(d2) + lam_init, oml = 1.0f - lam_init;
    volatile LAS int* uw = (volatile LAS int*)(lds + ATT_UNITW);
    const int myx = (int)(xb_xcc_id() & 7u);
    int qx = myx, tried = 0, ip = 0;
    if (tid == 0) ip = (int)atomicAdd(counters + 64 * qx, 1u);
    for (;;) {
        __syncthreads();
        if (tid == 0) {
            int got = -1, q = qx, tr = tried, i = ip;
            for (;;) { if (i < 260) { got = q * 260 + i; break; } q = (q + 1) & 7; ++tr; if (tr >= 8) break; i = (int)atomicAdd(counters + 64 * q, 1u); }
            uw[0] = got; uw[1] = q; uw[2] = tr;
        }
        __syncthreads();
        const int u = rfl(uw[0]); qx = rfl(uw[1]); tried = rfl(uw[2]);
        if (u < 0) break;
        if (tid == 0) ip = (int)atomicAdd(counters + 64 * qx, 1u);
        const int q = u / 260, i = u % 260;
        if (i < 130) { const int j = NBLK - 1 - (i >> 1), bh = q + 8 * (i & 1); attn_unit<false>(lds, bh >> 2, bh & 3, j, QALL, KD, VD, GD, CF, a.subln + layer * 128, lam, oml, 1.42f * kinfd4[bh & 3], AO); }
        else { const int v = i - 130; const int j = NBLK - 1 - (v >> 1), bh = q + 8 * (v & 1); const int g = bh & 3; const float kinf = fmaxf(kinf8[2 * g], kinf8[2 * g + 1]);
               attn_unit<true>(lds, bh >> 2, g, j, QALL, KF, VF, GF, CF, nullptr, 0.f, 0.f, kinf, AO); }
    }
}

__global__ void __launch_bounds__(512, 2) hymba_fwd(Args a) {
    extern __shared__ __attribute__((aligned(16))) unsigned char lds_raw[];
    LAS unsigned char* lds = (LAS unsigned char*)lds_raw;
    cg::grid_group grid = cg::this_grid();
    unsigned* ctl = (unsigned*)(a.ws + WS_CTL);
    const bf16_t* HN = (const bf16_t*)(a.ws + WS_HN);
    bf16_t* QALL = (bf16_t*)(a.ws + WS_QALL);
    if (threadIdx.x < 2) ((volatile LAS unsigned*)(lds + ATT_UNITW + 256))[threadIdx.x] = 0u;
    __syncthreads();
    const XcdBarrier bar = xcd_barrier_post(ctl + CW_BAR, (volatile LAS unsigned*)(lds + ATT_UNITW + 256));
    prologue_phase(lds, a);
    __syncthreads();
    for (int layer = 0; layer < DEPTH; ++layer) {
        norm_phase(lds, a, layer);
        if (layer == 0) grid.sync(); else xcd_barrier(bar);
        cumfix_phase(lds, a);
        {
            pg8::Gemm g{(const bf16_t*)(a.ws + WS_H), (const bf16_t*)(a.ws + WS_WIN) + (size_t)layer * NPROJ * DM, MROWS, NPROJ, DM};
            pg8::StaticOrder S; S.init(GTOK, NPROJ, (int)gridDim.x, (int)blockIdx.x);
            EpiInProj E{QALL, (bf16_t*)(a.ws + WS_KD), (bf16_t*)(a.ws + WS_VD), (bf16_t*)(a.ws + WS_GD), (bf16_t*)(a.ws + WS_KF), (bf16_t*)(a.ws + WS_VF), (bf16_t*)(a.ws + WS_GF),
                        (const float*)(a.ws + WS_ROPE), (const float*)(a.ws + WS_ROPE) + LP * 8, ctl + CW_KINF + layer * 8, ctl + CW_KINFD + layer * 4, (const float*)(a.ws + WS_RSTD)};
            meta_inproj(lds, (const bf16_t*)(a.ws + WS_H), (const bf16_t*)(a.ws + WS_WIN) + (size_t)layer * NPROJ * DM, E);
            pg8::gemm_phase<EpiInProj, pg8::StaticOrder, true, true>(lds, g, S, E);
        }
        xcd_barrier(bar);
        attn_phase(lds, a, layer, ctl + 64 * (1 + layer * 8));
        xcd_barrier(bar);
        {
            pg8::Gemm g{HN, (const bf16_t*)(a.ws + WS_WOUT) + (size_t)layer * DM * DM, MROWS, DM, DM};
            pg8::StaticOrder S; S.init(GTOK, DM, (int)gridDim.x, (int)blockIdx.x);
            EpiResid E{(bf16_t*)(a.ws + WS_Y)};
            meta_outproj(lds, HN, (const bf16_t*)(a.ws + WS_WOUT) + (size_t)layer * DM * DM, (bf16_t*)(a.ws + WS_Y));
            pg8::gemm_phase<EpiResid, pg8::StaticOrder, true, true>(lds, g, S, E);
        }
        xcd_barrier(bar);
    }
    final_phase(a);
}

extern "C" void kernel_launch(void* const* d_in, const int* in_sizes, int n_in, void* d_out, int out_size, void* d_ws, size_t ws_size, hipStream_t stream) {
    static int grid = 0;
    if (grid == 0) {
        if (n_in != 12 || ws_size < WS_END) { fprintf(stderr, "kernel_launch: bad inputs (n_in %d, ws %zu < %zu)\n", n_in, ws_size, (size_t)WS_END); grid = -1; return; }
        int dev = 0, cus = 0, per_cu = 0;
        hipGetDevice(&dev); hipDeviceGetAttribute(&cus, hipDeviceAttributeMultiprocessorCount, dev);
        if (hipFuncSetAttribute((const void*)hymba_fwd, hipFuncAttributeMaxDynamicSharedMemorySize, LDS_BYTES) != hipSuccess) { fprintf(stderr, "hipFuncSetAttribute failed\n"); grid = -1; return; }
        if (hipOccupancyMaxActiveBlocksPerMultiprocessor(&per_cu, (const void*)hymba_fwd, 512, LDS_BYTES) != hipSuccess || per_cu < 1) { fprintf(stderr, "occupancy query: %d\n", per_cu); per_cu = 1; }
        (void)hipGetLastError();
        grid = cus * per_cu;
    }
    if (grid < 0) return;
    (void)hipMemsetAsync((char*)d_ws + WS_CTL, 0, CTL_BYTES, stream);
    Args a{};
    a.x = (const float*)d_in[0]; a.meta = (const float*)d_in[1]; a.norm_gain = (const float*)d_in[2]; a.w_in = (const float*)d_in[3]; a.forget_bias = (const float*)d_in[4];
    a.lq1 = (const float*)d_in[5]; a.lk1 = (const float*)d_in[6]; a.lq2 = (const float*)d_in[7]; a.lk2 = (const float*)d_in[8]; a.subln = (const float*)d_in[9];
    a.w_out = (const float*)d_in[10]; a.final_gain = (const float*)d_in[11];
    a.out = (float*)d_out; a.ws = (unsigned char*)d_ws;
    for (int l = 0; l < 4; ++l) a.lam_init[l] = (float)(0.8 - 0.6 * exp(-0.3 * (double)l));
    for (int i = 0; i < 8; ++i) a.inv_freq[i] = (float)(1.0 / pow(500000.0, (double)(2 * i) / 16.0));
    void* args[] = {&a};
    hipError_t e = hipLaunchCooperativeKernel((const void*)hymba_fwd, dim3(grid), dim3(512), args, LDS_BYTES, stream);
    if (e != hipSuccess) fprintf(stderr, "cooperative launch failed: %s (grid %d)\n", hipGetErrorString(e), grid);
}
```
